# Optimizing an MI355X kernel written in HIP

```python
import math
import jax, jax.numpy as jnp
from jax import lax
import numpy as np

D_MODEL = 1024
BATCH = 16
SEQ = 256
DEPTH = 1
DEC_BATCH = 8
DEC_SEQ = 1024
PAST_LEN = 256

GRID_W = 64
D_ATTN = 512
D_SSM = 512
N_HEADS = 4
QK_DIM = 64
V_DIM = 2 * QK_DIM
SSM_GROUP_CH = 16
N_SSM_GROUPS = D_SSM // SSM_GROUP_CH
SSM_STATE = 64
D_IN = 4 * D_ATTN + 2 * D_SSM
SPLITS = [D_ATTN, 2 * D_ATTN, 3 * D_ATTN, 4 * D_ATTN, 4 * D_ATTN + D_SSM]
ROPE_THETA = 10000.0
Q_BLOCK = 128
EPS = 1e-6
DT_MIN = 0.001
DT_MAX = 0.1

kernel_name = "hybrid_diffattn_s5_prefix_step"


def rmsnorm(x, g):
    xf = x.astype(jnp.float32)
    y = xf * lax.rsqrt(jnp.mean(xf * xf, axis=-1, keepdims=True) + EPS)
    return (y * g.astype(jnp.float32)).astype(x.dtype)


def adaln(cond, w_ada, b_ada):
    m = jax.nn.silu(cond) @ w_ada + b_ada
    return jnp.split(m, 3, axis=-1)


def rope_2d(x):
    L = x.shape[1]
    rows = L // GRID_W
    row = jnp.repeat(jnp.arange(rows, dtype=jnp.float32), GRID_W)
    col = jnp.tile(jnp.arange(GRID_W, dtype=jnp.float32), rows)
    n_freq = QK_DIM // 4
    inv = ROPE_THETA ** (-jnp.arange(n_freq, dtype=jnp.float32) / n_freq)

    def rot(seg, pos):
        ang = pos[:, None] * inv
        cos = jnp.cos(ang)[None, :, None, None, :]
        sin = jnp.sin(ang)[None, :, None, None, :]
        s1 = seg[..., :n_freq].astype(jnp.float32)
        s2 = seg[..., n_freq:].astype(jnp.float32)
        return jnp.concatenate([s1 * cos - s2 * sin, s2 * cos + s1 * sin], axis=-1)

    half = QK_DIM // 2
    return jnp.concatenate([rot(x[..., :half], row), rot(x[..., half:], col)], axis=-1).astype(x.dtype)


def diff_attention(q, k, v, lam):
    b, Lq = q.shape[0], q.shape[1]
    nblk = Lq // Q_BLOCK
    qb = jnp.moveaxis(q.reshape(b, nblk, Q_BLOCK, N_HEADS, 2, QK_DIM), 1, 0)
    scale = QK_DIM ** -0.5

    def block(qblk):
        s = jnp.einsum('bqhcd,bkhcd->bhcqk', qblk, k).astype(jnp.float32) * scale
        p = jax.nn.softmax(s, axis=-1)
        w = p[:, :, 0] - lam * p[:, :, 1]
        return jnp.einsum('bhqk,bkhe->bqhe', w.astype(v.dtype), v)

    o = lax.map(block, qb)
    return jnp.moveaxis(o, 0, 1).reshape(b, Lq, N_HEADS, V_DIM)


def zoh(A_re, A_im, log_dt, B_re, B_im):
    A_re = A_re.astype(jnp.float32)
    A_im = A_im.astype(jnp.float32)
    dt = jnp.exp(log_dt.astype(jnp.float32))[:, None]
    mag = jnp.exp(A_re * dt)
    ab_re = mag * jnp.cos(A_im * dt)
    ab_im = mag * jnp.sin(A_im * dt)
    nr, ni = ab_re - 1.0, ab_im
    den = A_re * A_re + A_im * A_im
    f_re = (nr * A_re + ni * A_im) / den
    f_im = (ni * A_re - nr * A_im) / den
    B_re = B_re.astype(jnp.float32)
    B_im = B_im.astype(jnp.float32)
    bb_re = f_re[..., None] * B_re - f_im[..., None] * B_im
    bb_im = f_re[..., None] * B_im + f_im[..., None] * B_re
    return ab_re, ab_im, bb_re, bb_im


def complex_combine(e1, e2):
    a1r, a1i, b1r, b1i = e1
    a2r, a2i, b2r, b2i = e2
    return (a1r * a2r - a1i * a2i,
            a1r * a2i + a1i * a2r,
            a2r * b1r - a2i * b1i + b2r,
            a2r * b1i + a2i * b1r + b2i)


def ssm_scan(u, ab_re, ab_im, bb_re, bb_im, C_re, C_im, h0_re, h0_im, reverse):
    bu_re = jnp.einsum('blgh,gph->blgp', u, bb_re)
    bu_im = jnp.einsum('blgh,gph->blgp', u, bb_im)
    if reverse:
        bu_re = jnp.flip(bu_re, axis=1)
        bu_im = jnp.flip(bu_im, axis=1)
    first_re = bu_re[:, 0] + ab_re * h0_re - ab_im * h0_im
    first_im = bu_im[:, 0] + ab_re * h0_im + ab_im * h0_re
    bu_re = bu_re.at[:, 0].set(first_re)
    bu_im = bu_im.at[:, 0].set(first_im)
    a_re = jnp.broadcast_to(ab_re, bu_re.shape)
    a_im = jnp.broadcast_to(ab_im, bu_im.shape)
    _, _, h_re, h_im = lax.associative_scan(complex_combine, (a_re, a_im, bu_re, bu_im), axis=1)
    fin_re, fin_im = h_re[:, -1], h_im[:, -1]
    if reverse:
        h_re = jnp.flip(h_re, axis=1)
        h_im = jnp.flip(h_im, axis=1)
    y = (jnp.einsum('blgp,ghp->blgh', h_re, C_re.astype(jnp.float32))
         - jnp.einsum('blgp,ghp->blgh', h_im, C_im.astype(jnp.float32)))
    return y, fin_re, fin_im


def ssm_branch(u, h0, A_re, A_im, log_dt, B_re, B_im, C_re, C_im, D_skip, with_state):
    b, L = u.shape[0], u.shape[1]
    uf = u.astype(jnp.float32).reshape(b, L, N_SSM_GROUPS, SSM_GROUP_CH)
    h0 = h0.astype(jnp.float32)
    ys, fins = [], []
    for d in range(2):
        ab_re, ab_im, bb_re, bb_im = zoh(A_re[d], A_im[d], log_dt[d], B_re[d], B_im[d])
        y, fr, fi = ssm_scan(uf, ab_re, ab_im, bb_re, bb_im, C_re[d], C_im[d],
                             h0[:, d, 0], h0[:, d, 1], reverse=(d == 1))
        ys.append(y)
        fins.append(jnp.stack([fr, fi], axis=1))
    y = (ys[0] + ys[1]).reshape(b, L, D_SSM) + D_skip.astype(jnp.float32) * uf.reshape(b, L, D_SSM)
    if with_state:
        return y, jnp.stack(fins, axis=1)
    return y, None


def mixer_inputs(x, shift, scale, norm_pre, w_in):
    h = rmsnorm(x, norm_pre) * (1 + scale) + shift
    proj = h @ w_in
    q, k, v, g_attn, u, g_ssm = jnp.split(proj, SPLITS, axis=-1)
    b, L = x.shape[0], x.shape[1]
    q = q.reshape(b, L, N_HEADS, 2, QK_DIM)
    k = k.reshape(b, L, N_HEADS, 2, QK_DIM)
    v = v.reshape(b, L, N_HEADS, V_DIM)
    return q, k, v, g_attn, u, g_ssm


def mixer_output(x, o_attn, lam_init, g_attn, y_ssm, g_ssm, gate,
                 subln, w_glu, b_glu, w_out, norm_post):
    b, L = x.shape[0], x.shape[1]
    o = (rmsnorm(o_attn, subln) * (1 - lam_init)).reshape(b, L, D_ATTN) * jax.nn.silu(g_attn)
    ys = jax.nn.gelu(y_ssm.astype(x.dtype))
    ys = ys * jax.nn.sigmoid(ys @ w_glu + b_glu) * jax.nn.silu(g_ssm)
    out = jnp.concatenate([o, ys], axis=-1) @ w_out
    return x + gate * rmsnorm(out, norm_post)


def setup_inputs(seed: int = 0) -> dict:
    key = jax.random.key(seed)
    ks = jax.random.split(key, 26)
    f32 = jnp.float32
    G, P, Hc = N_SSM_GROUPS, SSM_STATE, SSM_GROUP_CH
    n_idx = jnp.arange(P, dtype=f32)
    return {
        "x_prompt": jax.random.normal(ks[0], (BATCH, SEQ, D_MODEL), f32),
        "x_sample": jax.random.normal(ks[1], (DEC_BATCH, DEC_SEQ, D_MODEL), f32),
        "cache_k": jax.random.normal(ks[2], (DEC_BATCH, DEPTH, PAST_LEN, N_HEADS, 2 * QK_DIM), f32),
        "cache_v": jax.random.normal(ks[3], (DEC_BATCH, DEPTH, PAST_LEN, N_HEADS, V_DIM), f32),
        "state_ssm": 0.1 * jax.random.normal(ks[4], (DEC_BATCH, DEPTH, 2, 2, G, P), f32),
        "c": jax.random.normal(ks[5], (DEC_BATCH, D_MODEL), f32),
        "c_ctx": jax.random.normal(ks[6], (D_MODEL,), f32),
        "w_ada": jax.random.normal(ks[7], (DEPTH, D_MODEL, 3 * D_MODEL), f32) * D_MODEL ** -0.5,
        "b_ada": 0.01 * jax.random.normal(ks[8], (DEPTH, 3 * D_MODEL), f32),
        "norm_pre": 1.0 + 0.05 * jax.random.normal(ks[9], (DEPTH, D_MODEL), f32),
        "norm_post": 1.0 + 0.05 * jax.random.normal(ks[10], (DEPTH, D_MODEL), f32),
        "w_in": jax.random.normal(ks[11], (DEPTH, D_MODEL, D_IN), f32) * D_MODEL ** -0.5,
        "lambda_qk": 0.1 * jax.random.normal(ks[12], (DEPTH, 4, QK_DIM), f32),
        "subln": 1.0 + 0.05 * jax.random.normal(ks[13], (DEPTH, V_DIM), f32),
        "ssm_A_re": -0.5 + 0.01 * jax.random.normal(ks[14], (DEPTH, 2, G, P), f32),
        "ssm_A_im": math.pi * n_idx + 0.01 * jax.random.normal(ks[15], (DEPTH, 2, G, P), f32),
        "ssm_log_dt": jax.random.uniform(ks[16], (DEPTH, 2, G), f32,
                                         minval=math.log(DT_MIN), maxval=math.log(DT_MAX)),
        "ssm_B_re": jax.random.normal(ks[17], (DEPTH, 2, G, P, Hc), f32) * (2 * Hc) ** -0.5,
        "ssm_B_im": jax.random.normal(ks[18], (DEPTH, 2, G, P, Hc), f32) * (2 * Hc) ** -0.5,
        "ssm_C_re": jax.random.normal(ks[19], (DEPTH, 2, G, Hc, P), f32) * (2 * P) ** -0.5,
        "ssm_C_im": jax.random.normal(ks[20], (DEPTH, 2, G, Hc, P), f32) * (2 * P) ** -0.5,
        "ssm_D": jax.random.normal(ks[21], (DEPTH, D_SSM), f32),
        "w_glu": jax.random.normal(ks[22], (DEPTH, D_SSM, D_SSM), f32) * D_SSM ** -0.5,
        "b_glu": 0.01 * jax.random.normal(ks[23], (DEPTH, D_SSM), f32),
        "w_out": jax.random.normal(ks[24], (DEPTH, D_ATTN + D_SSM, D_MODEL), f32) * (D_ATTN + D_SSM) ** -0.5,
    }


def reference(x_prompt, x_sample, cache_k, cache_v, state_ssm, c, c_ctx, w_ada, b_ada,
              norm_pre, norm_post, w_in, lambda_qk, subln, ssm_A_re, ssm_A_im, ssm_log_dt,
              ssm_B_re, ssm_B_im, ssm_C_re, ssm_C_im, ssm_D, w_glu, b_glu, w_out):
    xp, xs = x_prompt, x_sample
    bp, Lp = xp.shape[0], xp.shape[1]
    new_k, new_v, new_s = [], [], []
    for l in range(DEPTH):
        lam_init = 0.8 - 0.6 * math.exp(-0.3 * l)
        lq = lambda_qk[l].astype(jnp.float32)
        lam = jnp.exp(jnp.sum(lq[0] * lq[1])) - jnp.exp(jnp.sum(lq[2] * lq[3])) + lam_init
        ssm_p = (ssm_A_re[l], ssm_A_im[l], ssm_log_dt[l], ssm_B_re[l], ssm_B_im[l],
                 ssm_C_re[l], ssm_C_im[l], ssm_D[l])
        out_p = (subln[l], w_glu[l], b_glu[l], w_out[l], norm_post[l])

        shift, scale, gate = adaln(c_ctx, w_ada[l], b_ada[l])
        q, k, v, g_attn, u, g_ssm = mixer_inputs(xp, shift, scale, norm_pre[l], w_in[l])
        o = diff_attention(q, k, v, lam)
        h0 = jnp.zeros((bp, 2, 2, N_SSM_GROUPS, SSM_STATE), jnp.float32)
        y, fin = ssm_branch(u, h0, *ssm_p, with_state=True)
        new_k.append(k.reshape(bp, Lp, N_HEADS, 2 * QK_DIM))
        new_v.append(v)
        new_s.append(fin.astype(xp.dtype))
        xp = mixer_output(xp, o, lam_init, g_attn, y, g_ssm, gate, *out_p)

        bs, Ls = xs.shape[0], xs.shape[1]
        shift, scale, gate = [m[:, None, :] for m in adaln(c, w_ada[l], b_ada[l])]
        q, k, v, g_attn, u, g_ssm = mixer_inputs(xs, shift, scale, norm_pre[l], w_in[l])
        q = rope_2d(q)
        k = rope_2d(k)
        ck = cache_k[:, l]
        k_all = jnp.concatenate([ck.reshape(bs, ck.shape[1], N_HEADS, 2, QK_DIM).astype(k.dtype), k], axis=1)
        v_all = jnp.concatenate([cache_v[:, l].astype(v.dtype), v], axis=1)
        o = diff_attention(q, k_all, v_all, lam)
        y, _ = ssm_branch(u, state_ssm[:, l], *ssm_p, with_state=False)
        xs = mixer_output(xs, o, lam_init, g_attn, y, g_ssm, gate, *out_p)

    new_cache_k = jnp.stack(new_k, axis=1)
    new_cache_v = jnp.stack(new_v, axis=1)
    new_state_ssm = jnp.stack(new_s, axis=1)
    return (xp, xs, new_cache_k, new_cache_v, new_state_ssm)
```

```cpp
#include <hip/hip_runtime.h>
#include <cstdint>
#include <cstdio>
#include <cmath>

typedef unsigned short bf16_t;
#define GAS __attribute__((address_space(1)))
#define LAS __attribute__((address_space(3)))
typedef unsigned v4u __attribute__((ext_vector_type(4)));
typedef unsigned v2u __attribute__((ext_vector_type(2)));
typedef float f32x4 __attribute__((ext_vector_type(4)));
typedef short bf16x8 __attribute__((ext_vector_type(8)));
typedef GAS unsigned gu32;
typedef GAS unsigned long long gu64;
#define RLX_AGENT __ATOMIC_RELAXED, __HIP_MEMORY_SCOPE_AGENT
#define LDS_WAIT() asm volatile("s_waitcnt lgkmcnt(0)" ::: "memory")
#define VM_WAIT() asm volatile("s_waitcnt vmcnt(0)" ::: "memory")
__device__ __forceinline__ unsigned f2bf(float f) { unsigned u = __builtin_bit_cast(unsigned, f); return (u + 0x7fffu + ((u >> 16) & 1u)) >> 16; }
__device__ __forceinline__ unsigned pk2(float lo, float hi) { return f2bf(lo) | (f2bf(hi) << 16); }
__device__ __forceinline__ float bf2f(bf16_t h) { return __uint_as_float(((unsigned)h) << 16); }
__device__ __forceinline__ float bflo(unsigned w) { return __uint_as_float(w << 16); }
__device__ __forceinline__ float bfhi(unsigned w) { return __uint_as_float(w & 0xffff0000u); }
__device__ __forceinline__ float wave_sum(float v) {
#pragma unroll
    for (int o = 1; o < 64; o <<= 1) v += __shfl_xor(v, o);
    return v;
}
__device__ __forceinline__ float wave_max(float v) {
#pragma unroll
    for (int o = 1; o < 64; o <<= 1) v = fmaxf(v, __shfl_xor(v, o));
    return v;
}
__device__ __forceinline__ float siluf(float x) { return x / (1.f + expf(-x)); }
__device__ __forceinline__ float sigmoidf(float x) { return 1.f / (1.f + expf(-x)); }
__device__ __forceinline__ float fast_sigmoid(float x) { return __builtin_amdgcn_rcpf(1.f + __builtin_amdgcn_exp2f(-1.4426950408889634f * x)); }
__device__ __forceinline__ float fast_silu(float x) { return x * fast_sigmoid(x); }
__device__ __forceinline__ float gelu_tanh(float x) { const float c = 0.7978845608028654f; return 0.5f * x * (1.f + tanhf(c * (x + 0.044715f * x * x * x))); }
__device__ __forceinline__ float fast_gelu_tanh(float x) { const float c2 = 1.5957691216057308f; return x * fast_sigmoid(c2 * (x + 0.044715f * x * x * x)); }

constexpr int DM = 1024, NTOK_I = 4096, NTOK = 12288, DIN = 3072;
constexpr int NKROWS = 4096 + 8 * 1280;
constexpr float EPS = 1e-6f, LAM_INIT = 0.2f;
constexpr size_t O_YP = 0, O_YS = 4194304, O_NK = 12582912, O_NV = 14680064, O_NS = 16777216;

constexpr size_t MiB = 1u << 20;
constexpr size_t WS_CTL = 0, CTL_ZERO_BYTES = 256 * 1024;
constexpr size_t WS_MOD = 1 * MiB + 128 * 1024;
constexpr size_t WS_MISC = 1 * MiB;
constexpr size_t WS_ROPE = WS_MISC + 1024;
constexpr size_t WS_WIN = 2 * MiB;
constexpr size_t WS_WGLU = 8 * MiB;
constexpr size_t WS_WOUT = 9 * MiB;
constexpr size_t WS_XN = 12 * MiB;
constexpr size_t WS_Q = 36 * MiB;
constexpr size_t WS_K = 48 * MiB;
constexpr size_t WS_V = 62 * MiB;
constexpr size_t WS_GA = 76 * MiB;
constexpr size_t WS_U = 88 * MiB;
constexpr size_t WS_GS = 100 * MiB;
constexpr size_t WS_YS = 112 * MiB;
constexpr size_t WS_CAT = 124 * MiB;
constexpr size_t WS_OUT = 148 * MiB;
constexpr size_t WS_YF = 196 * MiB;
constexpr size_t WS_YB = 220 * MiB;
constexpr size_t WS_SSMW = 244 * MiB;
constexpr size_t WS_SIDE = 1 * MiB + 64 * 1024;
constexpr size_t WS_END = 256 * MiB;
static_assert(WS_ROPE + 8192 <= WS_SIDE && WS_SIDE + 65536 <= WS_MOD && WS_MOD + 8 * 9 * 3072 * 4 <= WS_WIN, "small-table map");

__device__ __forceinline__ int mod_index(int m) { return m < NTOK_I ? 0 : 1 + ((m - NTOK_I) >> 10); }
__device__ __forceinline__ int key_row(int m) { return m < NTOK_I ? m : 4096 + ((m - NTOK_I) >> 10) * 1280 + 256 + ((m - NTOK_I) & 1023); }
namespace pg8 {
#define PG8_LAS __attribute__((address_space(3)))
typedef unsigned short bf16_t;
typedef short bf16x8 __attribute__((ext_vector_type(8)));
typedef float f32x4 __attribute__((ext_vector_type(4)));
typedef unsigned u32x4 __attribute__((ext_vector_type(4)));
constexpr int BM = 256, BK = 64, HALF = 128, HTB = HALF * BK * 2  , STAGE_BYTES = 8 * HTB, NXCD = 8, WGM = 8;

__host__ __device__ __forceinline__ int lds_byte(int r, int c) { const int st = (r >> 4) * 2 + (c >> 5), rr = r & 15, cc = c & 31, ob = rr * 64 + cc * 2; return st * 1024 + (ob ^ (((ob >> 9) & 1) << 5)); }
__host__ __device__ __forceinline__ void stage_rc(int b, int& R, int& C) { const int st = b / 1024, sb = b % 1024, swz = sb ^ (((sb >> 9) & 1) << 5); R = (st >> 1) * 16 + swz / 64; C = (st & 1) * 32 + (swz % 64) / 2; }
__host__ __device__ __forceinline__ int perm32(int rho) { const int n = rho >> 4, i = rho & 15; return 8 * (i >> 2) + 4 * n + (i & 3); }

struct Unit { int pm, pn; };
struct Gemm { const bf16_t* A; const bf16_t* Bt; int M, N, K; };

struct StaticOrder {
    int nM, nN, nwg, G, c;
    __host__ __device__ void init(int M, int N, int G_, int c_) { nM = M / BM; nN = N / BM; nwg = nM * nN; G = G_; c = c_; }
    __host__ __device__ bool next(int i, Unit& u) const {
        const long L = (long)i * G + c; if (L >= nwg) return false;
        int wgid = (int)L; { const int q = nwg / NXCD, r = nwg % NXCD, xcd = wgid % NXCD, off = wgid / NXCD; wgid = (xcd < r ? xcd * (q + 1) : r * (q + 1) + (xcd - r) * q) + off; }
        const int nig = WGM * nN, gid = wgid / nig, fm = gid * WGM, gsz = (nM - fm) < WGM ? (nM - fm) : WGM;
        u.pm = fm + ((wgid % nig) % gsz); u.pn = (wgid % nig) / gsz; return true;
    }
    __device__ __forceinline__ void a_ready(const Unit&) const {}
    __device__ __forceinline__ void done(const Unit&) const {}
};

__device__ __forceinline__ unsigned cvt_pk_bf16(float lo, float hi) { unsigned r; asm volatile("v_cvt_pk_bf16_f32 %0, %1, %2" : "=v"(r) : "v"(lo), "v"(hi)); return r; }
typedef float f32x2 __attribute__((ext_vector_type(2)));
template <class Epi, class Sched, bool ALIGN_EPI = false, bool SP2 = false>
__device__ __forceinline__ void gemm_phase(PG8_LAS unsigned char* lds, const Gemm g, const Sched& S, const Epi& E) {
    int tid_ = threadIdx.x; asm volatile("" : "+v"(tid_));
    const int tid = tid_, wid = __builtin_amdgcn_readfirstlane(tid >> 6), lane = tid & 63, wr = wid >> 2, wc = wid & 3, fr = lane & 15, fq = lane >> 4;
    const int K = g.K, nt = K / BK;
    unsigned voffA[2], voffB[2];
#pragma unroll
    for (int i = 0; i < 2; ++i) { int R, C; stage_rc(tid * 16 + i * 8192, R, C); const int Rb = Epi::PERM ? ((R & ~31) + perm32(R & 31)) : R;
        voffA[i] = (unsigned)(R * K + C) * 2u; voffB[i] = (unsigned)(Rb * K + C) * 2u; }
    const size_t kstep = (size_t)(BK * 2);
    const size_t hstep = (size_t)HALF * K * 2;
    const size_t tstep = 2 * hstep;
    const unsigned ldsw = (unsigned)wid * 1024u;
    const int aoff = lds_byte(wr * 64 + fr, fq * 8), boff = lds_byte(wc * 32 + fr, fq * 8);
#define PG8_SA(b, h) (((b) * 2 + (h)) * HTB)
#define PG8_SB(b, h) ((4 + (b) * 2 + (h)) * HTB)
#define PG8_STAGE(bufoff, gbase, voff) do { _Pragma("unroll") for (int _i = 0; _i < 2; ++_i) \
        __builtin_amdgcn_global_load_lds((const unsigned*)((const char*)(gbase) + (voff)[_i]), (PG8_LAS unsigned*)(lds + (bufoff) + ldsw + _i * 8192), 16, 0, 0); } while (0)
#define PG8_LDA(dst, b, h) do { _Pragma("unroll") for (int m = 0; m < 4; ++m) _Pragma("unroll") for (int k = 0; k < 2; ++k) dst[m][k] = *(const PG8_LAS bf16x8*)(lds + PG8_SA(b, h) + aoff + m * 2048 + k * 1024); } while (0)
#define PG8_LDB(dst, b, h) do { _Pragma("unroll") for (int n = 0; n < 2; ++n) _Pragma("unroll") for (int k = 0; k < 2; ++k) dst[n][k] = *(const PG8_LAS bf16x8*)(lds + PG8_SB(b, h) + boff + n * 2048 + k * 1024); } while (0)
#define PG8_MMA(ai, bj, At, Bt) do { __builtin_amdgcn_s_setprio(1); _Pragma("unroll") for (int m = 0; m < 4; ++m) _Pragma("unroll") for (int n = 0; n < 2; ++n) _Pragma("unroll") for (int k = 0; k < 2; ++k) \
        acc[ai][bj][m][n] = __builtin_amdgcn_mfma_f32_16x16x32_bf16(Bt[n][k], At[m][k], acc[ai][bj][m][n], 0, 0, 0); __builtin_amdgcn_s_setprio(0); } while (0)
#define PG8_WAIT_V(n) asm volatile("s_waitcnt vmcnt(" #n ")" ::: "memory")
#define PG8_WAIT_L(n) asm volatile("s_waitcnt lgkmcnt(" #n ")" ::: "memory")
#define PG8_BAR __builtin_amdgcn_s_barrier()
#define PG8_SCHED __builtin_amdgcn_sched_barrier(0)
    Unit cur, nxt; int ui = 0;
    if (!S.next(0, cur)) return;
    f32x4 acc[2][2][4][2];
#pragma unroll
    for (int a = 0; a < 2; ++a)
#pragma unroll
        for (int b = 0; b < 2; ++b)
#pragma unroll
            for (int m = 0; m < 4; ++m)
#pragma unroll
                for (int n = 0; n < 2; ++n) acc[a][b][m][n] = (f32x4){0.f, 0.f, 0.f, 0.f};
    bf16x8 At[4][2], B0[2][2], B1[2][2];
    const char* cA = (const char*)g.A + (size_t)cur.pm * tstep; const char* cB = (const char*)g.Bt + (size_t)cur.pn * tstep;
    S.a_ready(cur);
    if constexpr (SP2) {
        PG8_STAGE(PG8_SB(0, 0), cB, voffB); PG8_STAGE(PG8_SB(0, 1), cB + hstep, voffB); PG8_STAGE(PG8_SA(0, 0), cA, voffA); PG8_STAGE(PG8_SA(0, 1), cA + hstep, voffA);
        if (wr == 1) PG8_BAR;
        PG8_WAIT_V(2); PG8_BAR;
        PG8_STAGE(PG8_SB(1, 0), cB + kstep, voffB); PG8_STAGE(PG8_SA(1, 0), cA + kstep, voffA); PG8_STAGE(PG8_SB(1, 1), cB + hstep + kstep, voffB);
        PG8_WAIT_V(6); PG8_BAR;
    } else {
        PG8_STAGE(PG8_SB(0, 0), cB, voffB); PG8_STAGE(PG8_SA(0, 0), cA, voffA); PG8_STAGE(PG8_SB(0, 1), cB + hstep, voffB); PG8_STAGE(PG8_SA(0, 1), cA + hstep, voffA);
        if (wr == 1) PG8_BAR;
        PG8_WAIT_V(4); PG8_BAR;
        PG8_STAGE(PG8_SB(1, 0), cB + kstep, voffB); PG8_STAGE(PG8_SA(1, 0), cA + kstep, voffA); PG8_STAGE(PG8_SB(1, 1), cB + hstep + kstep, voffB);
        PG8_WAIT_V(6); PG8_BAR;
    }
    for (;;) {
        const bool has_next = S.next(ui + 1, nxt);
        const char* nA = has_next ? (const char*)g.A + (size_t)nxt.pm * tstep : cA; const char* nB = has_next ? (const char*)g.Bt + (size_t)nxt.pn * tstep : cB;
        for (int t = 0; t < nt; t += 2) {
            const bool last = (t == nt - 2);
            const char* a1 = cA + (size_t)(t + 1) * kstep;
            const char* a2 = last ? nA : cA + (size_t)(t + 2) * kstep; const char* b2 = last ? nB : cB + (size_t)(t + 2) * kstep;
            const char* a3 = a2 + kstep; const char* b3 = b2 + kstep;
            if (last && has_next) S.a_ready(nxt);
            if constexpr (SP2) {
            PG8_LDB(B0, 0, 0); PG8_LDB(B1, 0, 1); PG8_SCHED; PG8_LDA(At, 0, 0); PG8_STAGE(PG8_SA(1, 1), a1 + hstep, voffA);
            PG8_WAIT_V(8); PG8_WAIT_L(0); PG8_BAR; PG8_MMA(0, 0, At, B0); PG8_MMA(0, 1, At, B1); PG8_BAR; PG8_SCHED;
            PG8_LDA(At, 0, 1); PG8_STAGE(PG8_SB(0, 0), b2, voffB); PG8_STAGE(PG8_SB(0, 1), b2 + hstep, voffB); PG8_STAGE(PG8_SA(0, 0), a2, voffA);
            PG8_WAIT_V(8); PG8_WAIT_L(0); PG8_BAR; PG8_MMA(1, 0, At, B0); PG8_MMA(1, 1, At, B1); PG8_BAR; PG8_SCHED;
            PG8_LDB(B0, 1, 0); PG8_LDB(B1, 1, 1); PG8_SCHED; PG8_LDA(At, 1, 0); PG8_STAGE(PG8_SA(0, 1), a2 + hstep, voffA);
            PG8_WAIT_V(8); PG8_WAIT_L(0); PG8_BAR; PG8_MMA(0, 0, At, B0); PG8_MMA(0, 1, At, B1); PG8_BAR; PG8_SCHED;
            PG8_LDA(At, 1, 1); PG8_STAGE(PG8_SB(1, 0), b3, voffB); PG8_STAGE(PG8_SB(1, 1), b3 + hstep, voffB); PG8_STAGE(PG8_SA(1, 0), a3, voffA);
            PG8_WAIT_V(8); PG8_WAIT_L(0); PG8_BAR; PG8_MMA(1, 0, At, B0); PG8_MMA(1, 1, At, B1); PG8_BAR; PG8_SCHED;
            } else {
            PG8_LDB(B0, 0, 0); PG8_SCHED; PG8_LDA(At, 0, 0); PG8_STAGE(PG8_SA(1, 1), a1 + hstep, voffA);
            PG8_WAIT_L(8); PG8_BAR; PG8_WAIT_L(0); PG8_MMA(0, 0, At, B0); PG8_BAR; PG8_SCHED;
            PG8_LDB(B1, 0, 1); PG8_STAGE(PG8_SB(0, 0), b2, voffB);
            PG8_BAR; PG8_WAIT_L(0); PG8_MMA(0, 1, At, B1); PG8_BAR;
            PG8_LDA(At, 0, 1); PG8_STAGE(PG8_SA(0, 0), a2, voffA);
            PG8_BAR; PG8_WAIT_L(0); PG8_MMA(1, 0, At, B0); PG8_BAR; PG8_SCHED;
            PG8_STAGE(PG8_SB(0, 1), b2 + hstep, voffB);
            PG8_WAIT_V(6); PG8_BAR; PG8_MMA(1, 1, At, B1); PG8_BAR;
            PG8_LDB(B0, 1, 0); PG8_SCHED; PG8_LDA(At, 1, 0); PG8_STAGE(PG8_SA(0, 1), a2 + hstep, voffA);
            PG8_WAIT_L(8); PG8_BAR; PG8_WAIT_L(0); PG8_MMA(0, 0, At, B0); PG8_BAR; PG8_SCHED;
            PG8_LDB(B1, 1, 1); PG8_STAGE(PG8_SB(1, 0), b3, voffB);
            PG8_BAR; PG8_WAIT_L(0); PG8_MMA(0, 1, At, B1); PG8_BAR;
            PG8_LDA(At, 1, 1); PG8_STAGE(PG8_SA(1, 0), a3, voffA);
            PG8_BAR; PG8_WAIT_L(0); PG8_MMA(1, 0, At, B0); PG8_BAR; PG8_SCHED;
            PG8_STAGE(PG8_SB(1, 1), b3 + hstep, voffB);
            PG8_WAIT_V(6); PG8_BAR; PG8_MMA(1, 1, At, B1); PG8_BAR;
            }
        }
        if constexpr (ALIGN_EPI) { if (wr == 0) PG8_BAR; }
        if constexpr (!Epi::AFTER_DRAIN) { E(acc, cur, wr, wc, fr, fq); S.done(cur); }
        if (!has_next) break;
#pragma unroll
        for (int a = 0; a < 2; ++a)
#pragma unroll
            for (int b = 0; b < 2; ++b)
#pragma unroll
                for (int m = 0; m < 4; ++m)
#pragma unroll
                    for (int n = 0; n < 2; ++n) acc[a][b][m][n] = (f32x4){0.f, 0.f, 0.f, 0.f};
        cur = nxt; cA = nA; cB = nB; ++ui;
        if constexpr (ALIGN_EPI) { if (wr == 1) PG8_BAR; }
    }
    PG8_WAIT_V(0);
    if constexpr (!ALIGN_EPI) { if (wr == 0) PG8_BAR; }
    PG8_BAR;
    if constexpr (Epi::AFTER_DRAIN) { E.fused(acc, cur, wr, wc, fr, fq, lds, wid, lane); S.done(cur); }
#undef PG8_SA
#undef PG8_SB
#undef PG8_STAGE
#undef PG8_LDA
#undef PG8_LDB
#undef PG8_MMA
#undef PG8_WAIT_V
#undef PG8_WAIT_L
#undef PG8_BAR
#undef PG8_SCHED
}
}
#define XB_TMO      128
#define XB_XCNT(j)  (256  + 64 * (j))
#define XB_XSUB(j)  (1280 + 64 * (j))
#define XB_XGEN(j)  (2304 + 64 * (j))
#define XB_TOP      3328
#define XB_TOPGEN   3392
#define XCD_BAR_WORDS 3456
#define XB_SPIN_CAP (1u << 18)

__device__ __forceinline__ unsigned xb_ld(unsigned* p)              { return __hip_atomic_load(p, __ATOMIC_RELAXED, __HIP_MEMORY_SCOPE_AGENT); }
__device__ __forceinline__ unsigned xb_add(unsigned* p, unsigned v) { return __hip_atomic_fetch_add(p, v, __ATOMIC_RELAXED, __HIP_MEMORY_SCOPE_AGENT); }
__device__ __forceinline__ unsigned xb_xcc_id() { return (unsigned)__builtin_amdgcn_s_getreg((3 << 11) | 20) & 0xFu; }
#define XB_SPIN(cond, bar) do { unsigned _sp = 0; while (cond) { __builtin_amdgcn_s_sleep(1); \
    if ((++_sp & 255u) == 0u) { if (xb_ld(&(bar)[XB_TMO])) break; if (_sp > XB_SPIN_CAP) { atomicAdd(&(bar)[XB_TMO], 1u); break; } } } } while (0)

struct XcdBarrier {
    unsigned* bar; unsigned x;
    volatile LAS unsigned* st;
};

__device__ __forceinline__ XcdBarrier xcd_barrier_post(unsigned* bar, volatile LAS unsigned* st) {
    XcdBarrier b; b.bar = bar; b.x = xb_xcc_id(); b.st = st;
    if (threadIdx.x == 0) (void)xb_add(&bar[XB_XCNT(b.x)], 1u);
    return b;
}
__device__ __forceinline__ void xcd_barrier_complete(unsigned* bar, unsigned x, unsigned& nloc, unsigned& nx) {
    const unsigned G = gridDim.x * gridDim.y * gridDim.z;
    unsigned sum, cnt, mine, sp = 0u;
    for (;;) {
        sum = 0u; cnt = 0u; mine = 0u;
#pragma unroll
        for (unsigned j = 0; j < 16; ++j) { const unsigned c = xb_ld(&bar[XB_XCNT(j)]); sum += c; cnt += (c > 0u) ? 1u : 0u; mine = (j == x) ? c : mine; }
        if (sum == G) break;
        __builtin_amdgcn_s_sleep(1);
        if ((++sp & 255u) == 0u) { if (xb_ld(&bar[XB_TMO])) break; if (sp > XB_SPIN_CAP) { atomicAdd(&bar[XB_TMO], 1u); break; } }
    }
    nloc = mine > 0u ? mine : 1u; nx = cnt > 0u ? cnt : 1u;
}

__device__ __forceinline__ void xcd_barrier(const XcdBarrier& b) {
    asm volatile("s_waitcnt vmcnt(0)" ::: "memory");
    __syncthreads();
    if (threadIdx.x == 0) {
        unsigned* bar = b.bar;
        __builtin_amdgcn_s_waitcnt(0);
        unsigned nloc = b.st[0], nx = b.st[1];
        if (nloc == 0u) { xcd_barrier_complete(bar, b.x, nloc, nx); b.st[0] = nloc; b.st[1] = nx; }
        const unsigned old = xb_add(&bar[XB_XSUB(b.x)], 1u);
        const unsigned gen = old / nloc;
        if (old + 1u == (gen + 1u) * nloc) {
            __builtin_amdgcn_fence(__ATOMIC_RELEASE, "agent");
            asm volatile("s_waitcnt vmcnt(0)" ::: "memory");
            const unsigned og = xb_add(&bar[XB_TOP], 1u);
            const unsigned tg = og / nx;
            if (og + 1u == (tg + 1u) * nx) xb_add(&bar[XB_TOPGEN], 1u);
            else XB_SPIN(xb_ld(&bar[XB_TOPGEN]) == tg, bar);
            __builtin_amdgcn_fence(__ATOMIC_ACQUIRE, "agent");
            xb_add(&bar[XB_XGEN(b.x)], 1u);
            asm volatile("s_waitcnt vmcnt(0)" ::: "memory");
        } else {
            XB_SPIN(xb_ld(&bar[XB_XGEN(b.x)]) == gen, bar);
            __builtin_amdgcn_fence(__ATOMIC_ACQUIRE, "agent");
            asm volatile("s_waitcnt vmcnt(0)" ::: "memory");
        }
    }
    __syncthreads();
}

namespace att {
using s16x4  = __attribute__((ext_vector_type(4))) short;
using f32x16 = __attribute__((ext_vector_type(16))) float;
using u32x4  = __attribute__((ext_vector_type(4))) unsigned;
constexpr int QBLK = 32, KVBLK = 64, LDK = 512, LDQ = 512;
constexpr float SCALE = 0.125f, THR = 8.f;
constexpr size_t SHM_V = KVBLK * 128 * 2, SHM_K = KVBLK * 128 * 2, SHM_ATTN = 2 * SHM_V + 2 * SHM_K + 8 * 64 * 4;
#define KSWZ(row, colB) ((row) * 256 + ((colB) ^ (((row) & 7) << 4)))
#define SBAR() __builtin_amdgcn_sched_barrier(0)
__device__ __forceinline__ int crow(int r, int hi) { return (r & 3) + 8 * (r >> 2) + 4 * hi; }
__device__ __forceinline__ unsigned cvtpk(float lo, float hi) { unsigned r; asm volatile("v_cvt_pk_bf16_f32 %0, %1, %2" : "=v"(r) : "v"(lo), "v"(hi)); return r; }
__device__ __forceinline__ bf16x8 ld8(const bf16_t* p) { return *reinterpret_cast<const bf16x8*>(p); }

__device__ __forceinline__ void partialSM(f32x16& p0, f32x16& p1, float& m_reg, float& mn, float& alpha) {
  constexpr float C = SCALE * 1.4426950408889634f;
  float pmax = p0[0]; for (int r = 1; r < 16; ++r) pmax = fmaxf(pmax, p0[r]); for (int r = 0; r < 16; ++r) pmax = fmaxf(pmax, p1[r]);
  { auto rr = __builtin_amdgcn_permlane32_swap(__float_as_uint(pmax), __float_as_uint(pmax), false, false);
    pmax = fmaxf(__uint_as_float(rr[0]), __uint_as_float(rr[1])); }
  if (__builtin_expect(__all(pmax - m_reg <= THR / SCALE), 1)) { mn = m_reg; alpha = 1.f; }
  else { mn = fmaxf(m_reg, pmax); alpha = __builtin_amdgcn_exp2f((m_reg - mn) * C); m_reg = mn; }
  float mnC = -mn * C;
  for (int r = 0; r < 16; ++r) p0[r] = fmaf(p0[r], C, mnC); for (int r = 0; r < 16; ++r) p1[r] = fmaf(p1[r], C, mnC);
  for (int r = 0; r < 16; ++r) p0[r] = __builtin_amdgcn_exp2f(p0[r]);
}
__device__ __forceinline__ void finishSM(f32x16& p0, f32x16& p1, float alpha, float& l_reg, bf16x8& pa0, bf16x8& pa1, bf16x8& pa2, bf16x8& pa3) {
  for (int r = 0; r < 16; ++r) p1[r] = __builtin_amdgcn_exp2f(p1[r]);
  float ps = 0; for (int r = 0; r < 16; ++r) ps += p0[r]; for (int r = 0; r < 16; ++r) ps += p1[r];
  { auto rr = __builtin_amdgcn_permlane32_swap(__float_as_uint(ps), __float_as_uint(ps), false, false);
    ps = __uint_as_float(rr[0]) + __uint_as_float(rr[1]); }
  l_reg = l_reg * alpha + ps;
#define PK4(P, BASE, OUT) do { unsigned a0 = cvtpk(P[BASE + 0], P[BASE + 1]), a1 = cvtpk(P[BASE + 2], P[BASE + 3]);   \
    unsigned b0 = cvtpk(P[BASE + 4], P[BASE + 5]), b1 = cvtpk(P[BASE + 6], P[BASE + 7]);                              \
    auto r0 = __builtin_amdgcn_permlane32_swap(a0, b0, false, false); auto r1 = __builtin_amdgcn_permlane32_swap(a1, b1, false, false); \
    u32x4 w = {r0[0], r1[0], r0[1], r1[1]}; OUT = *reinterpret_cast<bf16x8*>(&w); } while (0)
  PK4(p0, 0, pa0); PK4(p0, 8, pa1); PK4(p1, 0, pa2); PK4(p1, 8, pa3);
#undef PK4
}
__device__ __forceinline__ void qkt(f32x16& p0, f32x16& p1, const bf16_t* Ks, const bf16x8* qr, int r32, int hi, int c) {
  p0 = f32x16{}; p1 = f32x16{};
#pragma unroll
  for (int d0 = 0; d0 < 4; ++d0) { int cb = (c * 64 + d0 * 16 + hi * 8) * 2;
    bf16x8 b0 = *reinterpret_cast<const bf16x8*>((const char*)Ks + KSWZ(r32, cb));
    bf16x8 b1 = *reinterpret_cast<const bf16x8*>((const char*)Ks + KSWZ(32 + r32, cb));
    p0 = __builtin_amdgcn_mfma_f32_32x32x16_bf16(b0, qr[d0], p0, 0, 0, 0);
    p1 = __builtin_amdgcn_mfma_f32_32x32x16_bf16(b1, qr[d0], p1, 0, 0, 0); }
}
__device__ __forceinline__ int v_st(int k, int c) { const int kk = (k & ~0xC) | ((k & 4) << 1) | ((k & 8) >> 1); return ((kk >> 3) * 4 + (c >> 5)) * 512 + ((kk & 7) * 32 + (c & 31)) * 2; }
__device__ __forceinline__ int v_rd_base(int lane) { return ((lane & 3) << 3) | (((lane >> 2) & 3) << 6) | (((lane >> 4) & 1) << 5) | (((lane >> 5) & 1) << 8); }
constexpr int v_rd_off(int d0, int ks, int half) { return d0 * 512 + ks * 4096 + half * 2048; }
template <int OFF> __device__ __forceinline__ s16x4 tr_read(int vb) {
  s16x4 r; asm volatile("ds_read_b64_tr_b16 %0, %1 offset:%2" : "=&v"(r) : "v"(vb), "i"(OFF) : "memory"); return r;
}
template <int D0> __device__ __forceinline__ void pv_one(f32x16& od, int vb, bf16x8 pa0, bf16x8 pa1, bf16x8 pa2, bf16x8 pa3) {
  const s16x4 l0 = tr_read<v_rd_off(D0, 0, 0)>(vb), h0 = tr_read<v_rd_off(D0, 0, 1)>(vb), l1 = tr_read<v_rd_off(D0, 1, 0)>(vb), h1 = tr_read<v_rd_off(D0, 1, 1)>(vb);
  const s16x4 l2 = tr_read<v_rd_off(D0, 2, 0)>(vb), h2 = tr_read<v_rd_off(D0, 2, 1)>(vb), l3 = tr_read<v_rd_off(D0, 3, 0)>(vb), h3 = tr_read<v_rd_off(D0, 3, 1)>(vb);
  asm volatile("s_waitcnt lgkmcnt(0)" ::: "memory"); SBAR();
#define PK(L, H) (bf16x8){L[0], L[1], L[2], L[3], H[0], H[1], H[2], H[3]}
  od = __builtin_amdgcn_mfma_f32_32x32x16_bf16(pa0, PK(l0, h0), od, 0, 0, 0);
  od = __builtin_amdgcn_mfma_f32_32x32x16_bf16(pa1, PK(l1, h1), od, 0, 0, 0);
  od = __builtin_amdgcn_mfma_f32_32x32x16_bf16(pa2, PK(l2, h2), od, 0, 0, 0);
  od = __builtin_amdgcn_mfma_f32_32x32x16_bf16(pa3, PK(l3, h3), od, 0, 0, 0);
#undef PK
}
__device__ __forceinline__ void pv_d0(f32x16* o, int vb, bf16x8 pa0, bf16x8 pa1, bf16x8 pa2, bf16x8 pa3) {
  pv_one<0>(o[0], vb, pa0, pa1, pa2, pa3); pv_one<1>(o[1], vb, pa0, pa1, pa2, pa3); pv_one<2>(o[2], vb, pa0, pa1, pa2, pa3); pv_one<3>(o[3], vb, pa0, pa1, pa2, pa3);
}

__device__ __forceinline__ void attn_unit(const bf16_t* Qb, const bf16_t* Kh, const bf16_t* Vh, int seq, char* lds, float lam, const float* subln, const bf16_t* GAb, bf16_t* CATb) {
  int tid_ = threadIdx.x; asm volatile("" : "+v"(tid_));
  const int tid = tid_, wid = __builtin_amdgcn_readfirstlane(tid >> 6), lane = tid & 63, r32 = lane & 31, hi = lane >> 5, c = wid >> 2, wq = wid & 3;
  bf16_t* V_lds = (bf16_t*)lds; bf16_t* K_lds = (bf16_t*)(lds + 2 * SHM_V);
  float* ws = (float*)(lds + 2 * SHM_V + 2 * SHM_K) + wid * 64; float* li_l = ws; float* al_l = ws + 32;
  float m_reg = -1e30f, l_reg = 0; f32x16 o[4] = {}; bf16x8 qr[4];
  const bf16_t* Qw = Qb + (long)(wq * QBLK + r32) * LDQ + c * 64 + hi * 8;
#pragma unroll
  for (int d0 = 0; d0 < 4; ++d0) qr[d0] = ld8(Qw + d0 * 16);
  const int sr = tid >> 4, sc = (tid & 15) * 8, vst0 = v_st(sr, sc), vst1 = v_st(32 + sr, sc);
  const int vb0 = (int)(uintptr_t)V_lds + v_rd_base(lane);
  struct { bf16x8 vs0, vs1, ks0, ks1; } sr_[2];
#define SLOAD(i, k0) do { sr_[i].vs0 = ld8(&Vh[(long)((k0) + sr) * LDK + sc]); sr_[i].vs1 = ld8(&Vh[(long)((k0) + 32 + sr) * LDK + sc]); \
    sr_[i].ks0 = ld8(&Kh[(long)((k0) + sr) * LDK + sc]); sr_[i].ks1 = ld8(&Kh[(long)((k0) + 32 + sr) * LDK + sc]); } while (0)
#define SWRITE(b, i) do { *(bf16x8*)((char*)V_lds + (b) * SHM_V + vst0) = sr_[i].vs0;          \
    *(bf16x8*)((char*)V_lds + (b) * SHM_V + vst1) = sr_[i].vs1; int kc = sc * 2;               \
    *(bf16x8*)((char*)K_lds + (b) * SHM_K + KSWZ(sr, kc)) = sr_[i].ks0;                       \
    *(bf16x8*)((char*)K_lds + (b) * SHM_K + KSWZ(32 + sr, kc)) = sr_[i].ks1; } while (0)
#define SWAIT() asm volatile("s_waitcnt vmcnt(4)" ::: "memory")
#define RESC(a) do { if (__any((a) < 1.f)) { if (hi == 0) al_l[r32] = (a); asm volatile("s_waitcnt lgkmcnt(0)" ::: "memory"); \
    for (int d = 0; d < 4; ++d) for (int r = 0; r < 16; ++r) o[d][r] *= al_l[crow(r, hi)]; } } while (0)
  f32x16 pA0, pA1, pB0, pB1; float mnA, mnB, alA, alB; bf16x8 pa0, pa1, pa2, pa3; const int NT = seq / KVBLK;
  constexpr int SE = 0, SO = 1;
  SLOAD(SE, 0); asm volatile("s_waitcnt vmcnt(0)" ::: "memory"); SWRITE(0, SE); __syncthreads();
  qkt(pA0, pA1, K_lds, qr, r32, hi, c); partialSM(pA0, pA1, m_reg, mnA, alA);
  SLOAD(SO, KVBLK); if (2 < NT) SLOAD(SE, 2 * KVBLK);
  SWAIT(); SWRITE(1, SO); __syncthreads();
  for (int j = 1; j + 1 < NT; j += 2) {
    SBAR(); qkt(pB0, pB1, (bf16_t*)((char*)K_lds + SHM_K), qr, r32, hi, c);
    finishSM(pA0, pA1, alA, l_reg, pa0, pa1, pa2, pa3); SBAR();
    SLOAD(SO, (j + 2) * KVBLK); SBAR();
    pv_d0(o, vb0, pa0, pa1, pa2, pa3); partialSM(pB0, pB1, m_reg, mnB, alB);
    __syncthreads(); SWAIT(); SWRITE(0, SE);
    RESC(alB); __syncthreads();
    SBAR(); qkt(pA0, pA1, K_lds, qr, r32, hi, c);
    finishSM(pB0, pB1, alB, l_reg, pa0, pa1, pa2, pa3); SBAR();
    if (j + 3 < NT) SLOAD(SE, (j + 3) * KVBLK); SBAR();
    pv_d0(o, vb0 + (int)SHM_V, pa0, pa1, pa2, pa3); partialSM(pA0, pA1, m_reg, mnA, alA);
    __syncthreads(); SWAIT(); SWRITE(1, SO);
    RESC(alA); __syncthreads();
  }
  SBAR(); qkt(pB0, pB1, (bf16_t*)((char*)K_lds + SHM_K), qr, r32, hi, c);
  finishSM(pA0, pA1, alA, l_reg, pa0, pa1, pa2, pa3); SBAR();
  pv_d0(o, vb0, pa0, pa1, pa2, pa3); partialSM(pB0, pB1, m_reg, mnB, alB);
  __syncthreads(); RESC(alB);
  finishSM(pB0, pB1, alB, l_reg, pa0, pa1, pa2, pa3); SBAR();
  pv_d0(o, vb0 + (int)SHM_V, pa0, pa1, pa2, pa3);
  if (hi == 0) li_l[r32] = l_reg; asm volatile("s_waitcnt lgkmcnt(0)" ::: "memory");
  float rli[16];
#pragma unroll
  for (int r = 0; r < 16; ++r) rli[r] = __builtin_amdgcn_rcpf(li_l[crow(r, hi)]);
  __syncthreads();
  float* X = (float*)lds + (size_t)wq * (32 * 128);
  if (c == 1) {
#pragma unroll
    for (int r = 0; r < 16; ++r) { const int orow = crow(r, hi); const float f = rli[r] * lam;
#pragma unroll
      for (int d0 = 0; d0 < 4; ++d0) X[orow * 128 + d0 * 32 + r32] = o[d0][r] * f; }
  }
  __syncthreads();
  if (c == 0) {
    float sg[4];
#pragma unroll
    for (int d0 = 0; d0 < 4; ++d0) sg[d0] = subln[d0 * 32 + r32] * (1.f - LAM_INIT);
#pragma unroll
    for (int r = 0; r < 16; ++r) { const int orow = crow(r, hi); float v[4]; float ss = 0.f;
#pragma unroll
      for (int d0 = 0; d0 < 4; ++d0) { v[d0] = o[d0][r] * rli[r] - X[orow * 128 + d0 * 32 + r32]; ss += v[d0] * v[d0]; }
#pragma unroll
      for (int s = 1; s < 32; s <<= 1) ss += __shfl_xor(ss, s);
      const float rs = rsqrtf(ss * (1.f / 128.f) + EPS);
      const long grow = (long)(wq * QBLK + orow);
#pragma unroll
      for (int d0 = 0; d0 < 4; ++d0) { const int col = d0 * 32 + r32; const float g = bf2f(GAb[grow * 512 + col]);
        CATb[grow * 1024 + col] = (bf16_t)f2bf(v[d0] * rs * sg[d0] * g); } }
  }
  __syncthreads();
#undef SLOAD
#undef SWRITE
#undef SWAIT
#undef RESC
}
#undef KSWZ
#undef SBAR
}

namespace ssm {
using f32x16 = __attribute__((ext_vector_type(16))) float;
constexpr int SROW = 528;
constexpr size_t WA_ELEMS = 16 * 8 * 64 * 8, WC_ELEMS = 32 * 8 * 64 * 8, W_ELEMS = WA_ELEMS + WC_ELEMS;
constexpr int SIDE_F32 = 2 * 64 * 2 * 2;

struct Cplx { float re, im; };
__device__ __forceinline__ Cplx cmul(Cplx a, Cplx b) { return {a.re * b.re - a.im * b.im, a.re * b.im + a.im * b.re}; }

constexpr int NPART = 4;
__device__ __forceinline__ void precompute(int g, int part, const float* A_re, const float* A_im, const float* log_dt, const float* B_re, const float* B_im, const float* C_re, const float* C_im,
                                           const float* Dskip, bf16_t* W, float* side, LAS unsigned char* lds, int tid) {
    LAS float* apow = (LAS float*)lds;
    LAS float* bbar = (LAS float*)(lds + 17408);
    LAS float* Cc   = (LAS float*)(lds + 33792);
    LAS float* Kt   = (LAS float*)(lds + 50176);
    LAS float* Dl   = (LAS float*)(lds + 82944);
    LAS float* fz   = (LAS float*)(lds + 83008);
    if (tid < 128) { const int d = tid >> 6, p = tid & 63, dg = d * 32 + g;
        const float dt = expf(log_dt[dg]), Ar = A_re[dg * 64 + p], Ai = A_im[dg * 64 + p];
        const float mag = expf(Ar * dt); const Cplx ab = {mag * cosf(Ai * dt), mag * sinf(Ai * dt)};
        const float nr = ab.re - 1.f, ni = ab.im, den = Ar * Ar + Ai * Ai;
        fz[(d * 64 + p) * 2] = (nr * Ar + ni * Ai) / den; fz[(d * 64 + p) * 2 + 1] = (ni * Ar - nr * Ai) / den;
        Cplx pw = {1.f, 0.f};
        for (int m = 0; m <= 16; ++m) { apow[((d * 17 + m) * 64 + p) * 2] = pw.re; apow[((d * 17 + m) * 64 + p) * 2 + 1] = pw.im; if (m < 16) pw = cmul(pw, ab); }
        if (part == 0) { side[(d * 64 + p) * 2] = pw.re; side[(d * 64 + p) * 2 + 1] = pw.im;
            Cplx q = pw; for (int s = 0; s < 4; ++s) q = cmul(q, q);
            side[256 + (d * 64 + p) * 2] = q.re; side[256 + (d * 64 + p) * 2 + 1] = q.im; }
    }
    if (tid < 16) Dl[tid] = Dskip[g * 16 + tid];
    float br[4], bi[4];
#pragma unroll
    for (int j = 0; j < 4; ++j) { const int idx = tid + 512 * j, d = idx >> 10, rem = idx & 1023; const size_t o = (size_t)(d * 32 + g) * 1024 + rem;
        br[j] = B_re[o]; bi[j] = B_im[o]; Cc[idx * 2] = C_re[o]; Cc[idx * 2 + 1] = C_im[o]; }
    __syncthreads();
#pragma unroll
    for (int j = 0; j < 4; ++j) { const int idx = tid + 512 * j, dp = idx >> 4; const Cplx f = {fz[dp * 2], fz[dp * 2 + 1]}; const Cplx bb = cmul(f, (Cplx){br[j], bi[j]});
        bbar[idx * 2] = bb.re; bbar[idx * 2 + 1] = bb.im; }
    __syncthreads();
    { const int d = tid >> 8, m = (tid >> 4) & 15, hp = tid & 15; float sacc[16];
#pragma unroll
      for (int h = 0; h < 16; ++h) sacc[h] = 0.f;
#pragma unroll 2
      for (int p = 0; p < 64; ++p) { const Cplx c = {Cc[((d * 16 + hp) * 64 + p) * 2], Cc[((d * 16 + hp) * 64 + p) * 2 + 1]};
          const Cplx a = {apow[((d * 17 + m) * 64 + p) * 2], apow[((d * 17 + m) * 64 + p) * 2 + 1]}; const Cplx ca = cmul(c, a);
          const LAS f32x4* bp = (const LAS f32x4*)(bbar + (d * 64 + p) * 32);
#pragma unroll
          for (int h2 = 0; h2 < 8; ++h2) { const f32x4 b = bp[h2]; sacc[2 * h2] += ca.re * b.x - ca.im * b.y; sacc[2 * h2 + 1] += ca.re * b.z - ca.im * b.w; } }
#pragma unroll
      for (int h = 0; h < 16; ++h) Kt[tid * 16 + h] = sacc[h]; }
    __syncthreads();
    for (int o = part * (8192 / NPART) + tid; o < (part + 1) * (8192 / NPART); o += 512) { const int i = o >> 9, nt = (o >> 6) & 7, l = o & 63, d = nt >> 2, q = nt & 3, p = (l & 31) + 32 * (q >> 1), comp = q & 1, m = d == 0 ? 15 - i : i;
        const Cplx a = {apow[((d * 17 + m) * 64 + p) * 2], apow[((d * 17 + m) * 64 + p) * 2 + 1]};
        unsigned w[4];
#pragma unroll
        for (int e2 = 0; e2 < 4; ++e2) { float v[2];
#pragma unroll
            for (int t = 0; t < 2; ++t) { const int h = 8 * (l >> 5) + 2 * e2 + t; const Cplx b = {bbar[((d * 64 + p) * 16 + h) * 2], bbar[((d * 64 + p) * 16 + h) * 2 + 1]}; const Cplx z = cmul(a, b); v[t] = comp ? z.im : z.re; }
            w[e2] = pk2(v[0], v[1]); }
        *(GAS v4u*)(W + (size_t)o * 8) = (v4u){w[0], w[1], w[2], w[3]}; }
    for (int o = part * (16384 / NPART) + tid; o < (part + 1) * (16384 / NPART); o += 512) { const int ks = o >> 9, nt = (o >> 6) & 7, l = o & 63, cq = 32 * nt + (l & 31), j = cq >> 4, hp = cq & 15;
        unsigned w[4];
#pragma unroll
        for (int e2 = 0; e2 < 4; ++e2) { float v[2];
#pragma unroll
            for (int t = 0; t < 2; ++t) { const int e = 2 * e2 + t; float val;
                if (ks < 16) { const int i = ks, h = 8 * (l >> 5) + e; val = 0.f;
                    if (i <= j) val += Kt[((0 * 16 + (j - i)) * 16 + hp) * 16 + h];
                    if (i >= j) val += Kt[((1 * 16 + (i - j)) * 16 + hp) * 16 + h];
#ifndef SSM_PROBE
                    if (i == j && h == hp) val += Dl[h];
#endif
                    }
                else { const int kk = ks - 16, d = kk >> 3, kidx = 16 * (kk & 7) + 8 * (l >> 5) + e, p = kidx >> 1, comp = kidx & 1, m = d == 0 ? j + 1 : 16 - j;
                    const Cplx c = {Cc[((d * 16 + hp) * 64 + p) * 2], Cc[((d * 16 + hp) * 64 + p) * 2 + 1]};
                    const Cplx a = {apow[((d * 17 + m) * 64 + p) * 2], apow[((d * 17 + m) * 64 + p) * 2 + 1]};
                    const Cplx z = cmul(c, a); val = comp ? -z.im : z.re; }
                v[t] = val; }
            w[e2] = pk2(v[0], v[1]); }
        *(GAS v4u*)(W + WA_ELEMS + (size_t)o * 8) = (v4u){w[0], w[1], w[2], w[3]}; }
    __syncthreads();
}

template <int DIR, int KIND>
__device__ __forceinline__ void scan(const f32x16 (&x)[2][2], Cplx aT, Cplx aT16, Cplx h0, int hi, LAS unsigned char* SL, int col  , int mt0, Cplx (&fin)[2]) {
    Cplx cin[2];
    if (KIND == 1) {
        Cplx e[2];
#pragma unroll
        for (int m = 0; m < 2; ++m) { Cplx a = {0.f, 0.f};
#pragma unroll
            for (int s = 0; s < 16; ++s) { const int r = DIR ? 15 - s : s; const Cplx t = cmul(a, aT); a.re = t.re + x[m][0][r]; a.im = t.im + x[m][1][r]; }
            e[m] = a; }
        Cplx eo[2];
#pragma unroll
        for (int m = 0; m < 2; ++m) { eo[m].re = __shfl_xor(e[m].re, 32); eo[m].im = __shfl_xor(e[m].im, 32); }
        Cplx eA[2], eB[2];
#pragma unroll
        for (int m = 0; m < 2; ++m) { eA[m] = hi ? eo[m] : e[m]; eB[m] = hi ? e[m] : eo[m]; }
        Cplx c00, c01, c10, c11;
        if (DIR == 0) { c00 = h0; Cplx t = cmul(aT16, c00); c01 = {t.re + eA[0].re, t.im + eA[0].im}; t = cmul(aT16, c01); c10 = {t.re + eB[0].re, t.im + eB[0].im}; t = cmul(aT16, c10); c11 = {t.re + eA[1].re, t.im + eA[1].im}; }
        else { c11 = h0; Cplx t = cmul(aT16, c11); c10 = {t.re + eB[1].re, t.im + eB[1].im}; t = cmul(aT16, c10); c01 = {t.re + eA[1].re, t.im + eA[1].im}; t = cmul(aT16, c01); c00 = {t.re + eB[0].re, t.im + eB[0].im}; }
        cin[0] = hi ? c01 : c00; cin[1] = hi ? c11 : c10;
    } else { cin[0] = {0.f, 0.f}; cin[1] = {0.f, 0.f}; }
#pragma unroll
    for (int m = 0; m < 2; ++m) { Cplx s = cin[m];
#pragma unroll
        for (int q = 0; q < 16; ++q) { const int r = DIR ? 15 - q : q; const int rho = (r & 3) + 8 * (r >> 2) + 4 * hi;
            *(LAS unsigned*)(SL + ((mt0 + m) * 32 + rho) * 512 + ((((col >> 3) ^ (rho & 15)) << 4) | ((col & 7) * 2))) = pk2(s.re, s.im);
            const Cplx t = cmul(s, aT); s.re = t.re + x[m][0][r]; s.im = t.im + x[m][1][r]; }
        fin[m] = s; }
}

__device__ __forceinline__ int item_tok(int kind, int b0, int mt, int rho) { const int hr = (rho >> 2) & 1, rr = (rho & 3) + 4 * (rho >> 3);
    return kind ? NTOK_I + (b0 + (mt >> 1)) * 1024 + 16 * (32 * (mt & 1) + 16 * hr + rr) : (b0 + 2 * mt + hr) * 256 + 16 * rr; }
#define SSM_MMA4(ACC, A0, A1, B0, B1) do { \
        ACC[0][0] = __builtin_amdgcn_mfma_f32_32x32x16_bf16(A0, B0, ACC[0][0], 0, 0, 0); ACC[0][1] = __builtin_amdgcn_mfma_f32_32x32x16_bf16(A0, B1, ACC[0][1], 0, 0, 0); \
        ACC[1][0] = __builtin_amdgcn_mfma_f32_32x32x16_bf16(A1, B0, ACC[1][0], 0, 0, 0); ACC[1][1] = __builtin_amdgcn_mfma_f32_32x32x16_bf16(A1, B1, ACC[1][1], 0, 0, 0); } while (0)
__device__ __forceinline__ void item(int g, int kind, int b0, const bf16_t* U, const bf16_t* Wg, const float* side, const float* state_ssm, bf16_t* YS, float* out, LAS unsigned char* lds) {
    int tid_ = threadIdx.x; asm volatile("" : "+v"(tid_));
    const int tid = tid_, wid = __builtin_amdgcn_readfirstlane(tid >> 6), lane = tid & 63, r32 = lane & 31, hi = lane >> 5, mp = wid & 1, nq = wid >> 1;
    LAS unsigned char* UL = lds; LAS unsigned char* SL = lds + 65536;
    const bf16x8* WA = (const bf16x8*)Wg + 2 * nq * 64 + lane; const bf16x8* WC = (const bf16x8*)(Wg + WA_ELEMS) + 2 * nq * 64 + lane;
    {   v4u pc[8];
#pragma unroll
        for (int j = 0; j < 8; ++j) { const int id = tid + 512 * j, row = id >> 5, ch = id & 31;
            pc[j] = *(const GAS v4u*)(U + (size_t)(item_tok(kind, b0, row >> 5, row & 31) + (ch >> 1)) * 512 + g * 16 + (ch & 1) * 8); }
#pragma unroll
        for (int j = 0; j < 8; ++j) { const int id = tid + 512 * j, row = id >> 5, ch = id & 31; *(LAS v4u*)(UL + row * 512 + ((ch ^ (row & 15)) << 4)) = pc[j]; }
    }
    bf16x8 bq[4][2];
#pragma unroll
    for (int s4 = 0; s4 < 4; ++s4) { bq[s4][0] = WA[s4 * 512]; bq[s4][1] = WA[s4 * 512 + 64]; }
    __syncthreads();
    const LAS unsigned char* ua0 = UL + ((2 * mp) * 32 + r32) * 512; const LAS unsigned char* ua1 = ua0 + 32 * 512; const int sw = r32 & 15;
    f32x16 x[2][2];
#pragma unroll
    for (int m = 0; m < 2; ++m)
#pragma unroll
        for (int t = 0; t < 2; ++t) x[m][t] = f32x16{};
#define SSM_STEP(ACC, P0, P1, II, PREF) do { const bf16x8 a0 = *(const LAS bf16x8*)((P0) + (((2 * (II) + hi) ^ sw) << 4)), a1 = *(const LAS bf16x8*)((P1) + (((2 * (II) + hi) ^ sw) << 4)); \
        SSM_MMA4(ACC, a0, a1, bq[i & 3][0], bq[i & 3][1]); __builtin_amdgcn_sched_barrier(0); PREF; __builtin_amdgcn_sched_barrier(0); } while (0)
#pragma unroll 4
    for (int i = 0; i < 12; ++i) SSM_STEP(x, ua0, ua1, i, (bq[i & 3][0] = WA[(i + 4) * 512], bq[i & 3][1] = WA[(i + 4) * 512 + 64]));
#pragma unroll
    for (int i = 12; i < 16; ++i) SSM_STEP(x, ua0, ua1, i, (bq[i & 3][0] = WC[(i - 12) * 512], bq[i & 3][1] = WC[(i - 12) * 512 + 64]));
    { const int d = nq >> 1, p = r32 + 32 * (nq & 1);
      const Cplx aT = {side[(d * 64 + p) * 2], side[(d * 64 + p) * 2 + 1]}, aT16 = {side[256 + (d * 64 + p) * 2], side[256 + (d * 64 + p) * 2 + 1]};
      Cplx h0 = {0.f, 0.f};
      if (kind) { const size_t sb = ((size_t)((b0 + mp) * 2 + d) * 2) * 2048 + g * 64 + p; h0.re = state_ssm[sb]; h0.im = state_ssm[sb + 2048]; }
      Cplx fin[2];
      if (kind) { if (d == 0) scan<0, 1>(x, aT, aT16, h0, hi, SL, d * 128 + 2 * p, 2 * mp, fin); else scan<1, 1>(x, aT, aT16, h0, hi, SL, d * 128 + 2 * p, 2 * mp, fin); }
      else { if (d == 0) scan<0, 0>(x, aT, aT16, h0, hi, SL, d * 128 + 2 * p, 2 * mp, fin); else scan<1, 0>(x, aT, aT16, h0, hi, SL, d * 128 + 2 * p, 2 * mp, fin);
#pragma unroll
          for (int m = 0; m < 2; ++m) { const int b = b0 + 2 * (2 * mp + m) + hi; const size_t sb = ((size_t)(b * 2 + d) * 2) * 2048 + g * 64 + p; out[O_NS + sb] = fin[m].re; out[O_NS + sb + 2048] = fin[m].im; } }
    }
    __syncthreads();
    f32x16 y[2][2];
#pragma unroll
    for (int m = 0; m < 2; ++m)
#pragma unroll
        for (int t = 0; t < 2; ++t) y[m][t] = f32x16{};
    const LAS unsigned char* sa0 = SL + ((2 * mp) * 32 + r32) * 512; const LAS unsigned char* sa1 = sa0 + 32 * 512;
#pragma unroll 4
    for (int i = 0; i < 16; ++i) SSM_STEP(y, ua0, ua1, i, (bq[i & 3][0] = WC[(i + 4) * 512], bq[i & 3][1] = WC[(i + 4) * 512 + 64]));
#pragma unroll 4
    for (int i = 16; i < 28; ++i) SSM_STEP(y, sa0, sa1, i - 16, (bq[i & 3][0] = WC[(i + 4) * 512], bq[i & 3][1] = WC[(i + 4) * 512 + 64]));
#pragma unroll
    for (int i = 28; i < 32; ++i) SSM_STEP(y, sa0, sa1, i - 16, (void)0);
#undef SSM_STEP
    __syncthreads();
#pragma unroll
    for (int m = 0; m < 2; ++m)
#pragma unroll
        for (int r = 0; r < 16; ++r) { const int rho = (r & 3) + 8 * (r >> 2) + 4 * hi, row = (2 * mp + m) * 32 + rho;
#pragma unroll
            for (int t = 0; t < 2; ++t) { const int cq = 64 * nq + 32 * t + r32, ch = cq >> 3;
#ifdef SSM_PROBE
                { const int j = cq >> 4, hp = cq & 15; ((float*)YS)[(size_t)(item_tok(kind, b0, 2 * mp + m, rho) + j) * 512 + g * 16 + hp] = y[m][t][r]; }
#endif
                *(LAS bf16_t*)(UL + row * 512 + ((ch ^ (rho & 15)) << 4) + (cq & 7) * 2) = (bf16_t)f2bf(fast_gelu_tanh(y[m][t][r])); } }
    __syncthreads();
#ifndef SSM_PROBE
#pragma unroll
    for (int j = 0; j < 8; ++j) { const int id = tid + 512 * j, row = id >> 5, ch = id & 31;
        const v4u v = *(const LAS v4u*)(UL + row * 512 + ((ch ^ (row & 15)) << 4));
        *(GAS v4u*)(YS + (size_t)(item_tok(kind, b0, row >> 5, row & 31) + (ch >> 1)) * 512 + g * 16 + (ch & 1) * 8) = v; }
#endif
    __syncthreads();
}
#undef SSM_MMA4
}

constexpr int NWAVES = 8, NTHREADS = 512;
constexpr int RING_BYTES = 131072, LDSCTL_OFF = RING_BYTES, MISC_OFF = LDSCTL_OFF + 320, LDS_BYTES = 147456;
constexpr int CW_BAR = 4096;
static_assert((CW_BAR + XCD_BAR_WORDS) * 4 <= (int)CTL_ZERO_BYTES, "barrier words inside the memset region");
constexpr int NPHASE = 7;

struct Args { const float* in[25]; float* out; unsigned char* ws; int ph_lo, ph_hi; int rep[8]; int p3mask, pad; };

struct Frame {
    LAS unsigned char* lds; int tid, lane, wave, G;
    const float *x_prompt, *x_sample, *cache_k, *cache_v, *state_ssm, *c, *c_ctx, *w_ada, *b_ada, *norm_pre, *norm_post, *w_in, *lambda_qk, *subln;
    const float *A_re, *A_im, *log_dt, *B_re, *B_im, *C_re, *C_im, *ssm_D, *w_glu, *b_glu, *w_out;
    float* out; float *PART, *MISC, *ROPE, *OUT;
    bf16_t *WIN, *WGLU, *WOUT, *XN, *Q, *KALL, *VALL, *GA, *U, *GS, *YS, *CAT, *SSMW; float* SIDE;
};

__device__ __forceinline__ void p0_adaln_part(Frame& F, int wg) {
    const int kb = wg >> 5, cc = wg & 31;
    LAS float* sc = (LAS float*)F.lds;
    LAS float* red = (LAS float*)(F.lds + 8192);
    for (int i = F.tid; i < 9 * 128; i += NTHREADS) { const int ci = i >> 7, k = 128 * kb + (i & 127); const float v = ci == 0 ? F.c_ctx[k] : F.c[(ci - 1) * DM + k]; sc[i] = siluf(v); }
    __syncthreads();
    const int c4 = F.tid % 24, rg = F.tid / 24;
    if (rg < 21) {
        f32x4 w[7];
#pragma unroll
        for (int j = 0; j < 7; ++j) { const int r = rg + 21 * j; w[j] = r < 128 ? *(const GAS f32x4*)(F.w_ada + (size_t)(128 * kb + r) * DIN + 96 * cc + 4 * c4) : (f32x4){0.f, 0.f, 0.f, 0.f}; }
#pragma unroll
        for (int ci = 0; ci < 9; ++ci) { f32x4 a = {0.f, 0.f, 0.f, 0.f};
#pragma unroll
            for (int j = 0; j < 7; ++j) { const int r = rg + 21 * j; const float sv = r < 128 ? sc[ci * 128 + r] : 0.f; a += w[j] * sv; }
            *(LAS f32x4*)(red + (rg * 9 + ci) * 96 + 4 * c4) = a; }
    }
    __syncthreads();
    for (int o = F.tid; o < 9 * 96; o += NTHREADS) { float sum = 0.f;
#pragma unroll
        for (int r = 0; r < 21; ++r) sum += red[r * 864 + o];
        const int ci = o / 96, col = o % 96; F.PART[(size_t)(kb * 9 + ci) * DIN + 96 * cc + col] = sum; }
    __syncthreads();
}
__device__ __forceinline__ void mod_to_lds(Frame& F, LAS float* MODL, int ci0, int ci1, int col0, int n) {
    for (int i = F.tid; i < 2 * n; i += NTHREADS) { const int j = i >= n, col = col0 + (j ? i - n : i), ci = j ? ci1 : ci0; float sum = F.b_ada[col];
#pragma unroll
        for (int kb = 0; kb < 8; ++kb) sum += F.PART[(size_t)(kb * 9 + ci) * DIN + col];
        MODL[i] = sum; }
    __syncthreads();
}
__device__ __forceinline__ void p0_transpose_item(const float* W, int K, int N, bf16_t* WT, LAS float* scr, int item, int lane) {
    const int nblk = N / 32, kb = item / nblk, nb = item % nblk, k0 = 64 * kb, n0 = 32 * nb;
#pragma unroll 8
    for (int i = 0; i < 32; ++i) { const int kk = 2 * i + (lane >> 5); scr[kk * 33 + (lane & 31)] = W[(size_t)(k0 + kk) * N + n0 + (lane & 31)]; }
    LDS_WAIT(); asm volatile("" ::: "memory");
    const int c = lane & 7;
#pragma unroll
    for (int j = 0; j < 4; ++j) { const int n = (lane >> 3) + 8 * j; const LAS float* s = scr + (8 * c) * 33 + n;
        v4u o; o.x = pk2(s[0 * 33], s[1 * 33]); o.y = pk2(s[2 * 33], s[3 * 33]); o.z = pk2(s[4 * 33], s[5 * 33]); o.w = pk2(s[6 * 33], s[7 * 33]);
        *(GAS v4u*)(WT + (size_t)(n0 + n) * K + k0 + 8 * c) = o; }
    LDS_WAIT(); asm volatile("" ::: "memory");
}
__device__ __forceinline__ void p0_prologue(Frame& F, int pm) {
    const int wg = blockIdx.x;
    if (pm & 1) p0_adaln_part(F, wg);
    if ((pm & 2) && wg < 32 * ssm::NPART) { const int g = wg / ssm::NPART;
        ssm::precompute(g, wg % ssm::NPART, F.A_re, F.A_im, F.log_dt, F.B_re, F.B_im, F.C_re, F.C_im, F.ssm_D, F.SSMW + (size_t)g * ssm::W_ELEMS, F.SIDE + g * ssm::SIDE_F32, F.lds, F.tid); }
    if ((pm & 8) && wg == F.G - 1) {
        for (int t = F.tid; t < 1024; t += NTHREADS) { const int pos = t >> 4, f = t & 15; const float inv = powf(10000.f, -(float)f / 16.f), ang = (float)pos * inv;
            F.ROPE[pos * 16 + f] = cosf(ang); F.ROPE[1024 + pos * 16 + f] = sinf(ang); }
        if (F.tid == 0) { float s1 = 0.f, s2 = 0.f; for (int i = 0; i < 64; ++i) { s1 += F.lambda_qk[i] * F.lambda_qk[64 + i]; s2 += F.lambda_qk[128 + i] * F.lambda_qk[192 + i]; }
            F.MISC[0] = expf(s1) - expf(s2) + LAM_INIT; }
    }
    LAS float* scr = (LAS float*)(F.lds + F.wave * 16384);
    const int NGW = F.G * NWAVES, o = ((wg + F.G - 32 * ssm::NPART) % F.G) * NWAVES + F.wave;
    constexpr int I_IN = (DM / 64) * (DIN / 32), I_GLU = (512 / 64) * (512 / 32), I_OUT = (DM / 64) * (DM / 32), NITEMS = I_IN + I_GLU + I_OUT;
    if (pm & 4) for (int it = o; it < NITEMS; it += NGW) {
        int r = it;
        if (r < I_IN) { p0_transpose_item(F.w_in, DM, DIN, F.WIN, scr, r, F.lane); continue; } r -= I_IN;
        if (r < I_GLU) { p0_transpose_item(F.w_glu, 512, 512, F.WGLU, scr, r, F.lane); continue; } r -= I_GLU;
        p0_transpose_item(F.w_out, DM, DM, F.WOUT, scr, r, F.lane);
    }
    if (pm & 8) { const int n4 = 8 * 256 * 512 / 4;
        for (int i = wg * NTHREADS + F.tid; i < 2 * n4; i += F.G * NTHREADS) { const bool isv = i >= n4; const int j = isv ? i - n4 : i;
            const f32x4 v = ((const GAS f32x4*)(isv ? F.cache_v : F.cache_k))[j];
            const int b = j / (256 * 128), rem = j % (256 * 128); v2u w; w.x = pk2(v.x, v.y); w.y = pk2(v.z, v.w);
            ((GAS v2u*)((isv ? F.VALL : F.KALL) + (size_t)(4096 + b * 1280) * 512))[rem] = w; } }
}
__device__ __forceinline__ void p1_prep_x(Frame& F) {
    constexpr int RPB = NTOK / 256;
    const int row0 = blockIdx.x * RPB, ci0 = mod_index(row0), ci1 = mod_index(row0 + RPB - 1);
    LAS float* MODL = (LAS float*)F.lds;
    mod_to_lds(F, MODL, ci0, ci1, 0, 2048);
    for (int m = row0 + F.wave; m < row0 + RPB; m += NWAVES) {
        const float* xr = m < NTOK_I ? F.x_prompt + (size_t)m * DM : F.x_sample + (size_t)(m - NTOK_I) * DM;
        const LAS float* shift = MODL + (mod_index(m) == ci0 ? 0 : 2048); const LAS float* scale = shift + DM;
        f32x4 v[4]; float ss = 0.f;
#pragma unroll
        for (int j = 0; j < 4; ++j) { v[j] = ((const GAS f32x4*)xr)[F.lane + 64 * j]; ss += (v[j].x * v[j].x + v[j].y * v[j].y) + (v[j].z * v[j].z + v[j].w * v[j].w); }
        ss = wave_sum(ss); const float r = rsqrtf(ss * (1.f / DM) + EPS);
#pragma unroll
        for (int j = 0; j < 4; ++j) { const int i4 = F.lane + 64 * j;
            const f32x4 g = ((const GAS f32x4*)F.norm_pre)[i4], sc = ((const LAS f32x4*)scale)[i4], sh = ((const LAS f32x4*)shift)[i4];
            v2u o; o.x = pk2(v[j].x * r * g.x * (1.f + sc.x) + sh.x, v[j].y * r * g.y * (1.f + sc.y) + sh.y);
            o.y = pk2(v[j].z * r * g.z * (1.f + sc.z) + sh.z, v[j].w * r * g.w * (1.f + sc.w) + sh.w);
            ((GAS v2u*)(F.XN + (size_t)m * DM))[i4] = o; }
    }
    __syncthreads();
}
struct EpiIn {
    static constexpr bool PERM = false, AFTER_DRAIN = false;
    bf16_t *Q, *KALL, *VALL, *GA, *U, *GS; float* out; const float* ROPE;
    __device__ __forceinline__ void operator()(const pg8::f32x4 (&acc)[2][2][4][2], const pg8::Unit& u, int wr, int wc, int fr, int fq) const {
        const int sec = u.pn >> 1, cbase = (u.pn & 1) * 256 + wc * 32 + 4 * fq, rbase = u.pm * 256 + wr * 64 + fr;
        const bool g2 = u.pm >= 16, rope = g2 && sec < 2;
#pragma unroll
        for (int ai = 0; ai < 2; ++ai)
#pragma unroll
            for (int m = 0; m < 4; ++m) {
                const int r = rbase + 128 * ai + 16 * m;
                f32x4 cs = {1.f, 1.f, 1.f, 1.f}, sn = {0.f, 0.f, 0.f, 0.f};
                if (rope) { const int t = (r - NTOK_I) & 1023, pos = (wc & 1) ? (t & 63) : (t >> 6);
                    cs = *(const GAS f32x4*)(ROPE + pos * 16 + 4 * fq); sn = *(const GAS f32x4*)(ROPE + 1024 + pos * 16 + 4 * fq); }
                const size_t krow = (size_t)key_row(r);
#pragma unroll
                for (int bj = 0; bj < 2; ++bj) {
                    const f32x4 a0 = acc[ai][bj][m][0], a1 = acc[ai][bj][m][1];
                    const f32x4 v0 = a0 * cs - a1 * sn, v1 = a1 * cs + a0 * sn;
                    const int cc = cbase + 128 * bj;
                    if (sec == 0) { bf16_t* p = Q + (size_t)r * 512 + cc;
                        *(GAS v2u*)p = (v2u){pk2(v0.x, v0.y), pk2(v0.z, v0.w)}; *(GAS v2u*)(p + 16) = (v2u){pk2(v1.x, v1.y), pk2(v1.z, v1.w)}; }
                    else if (sec == 1 || sec == 2) { bf16_t* p = (sec == 1 ? KALL : VALL) + krow * 512 + cc;
                        *(GAS v2u*)p = (v2u){pk2(v0.x, v0.y), pk2(v0.z, v0.w)}; *(GAS v2u*)(p + 16) = (v2u){pk2(v1.x, v1.y), pk2(v1.z, v1.w)};
                        if (!g2) { float* o = out + (sec == 1 ? O_NK : O_NV) + (size_t)r * 512 + cc; *(GAS f32x4*)o = v0; *(GAS f32x4*)(o + 16) = v1; } }
                    else if (sec == 4) { bf16_t* p = U + (size_t)r * 512 + cc;
                        *(GAS v2u*)p = (v2u){pk2(v0.x, v0.y), pk2(v0.z, v0.w)}; *(GAS v2u*)(p + 16) = (v2u){pk2(v1.x, v1.y), pk2(v1.z, v1.w)}; }
                    else { bf16_t* p = (sec == 3 ? GA : GS) + (size_t)r * 512 + cc;
                        *(GAS v2u*)p = (v2u){pk2(fast_silu(v0.x), fast_silu(v0.y)), pk2(fast_silu(v0.z), fast_silu(v0.w))};
                        *(GAS v2u*)(p + 16) = (v2u){pk2(fast_silu(v1.x), fast_silu(v1.y)), pk2(fast_silu(v1.z), fast_silu(v1.w))}; }
                }
            }
    }
};

struct EpiGlu {
    static constexpr bool PERM = true, AFTER_DRAIN = false;
    const bf16_t *YS, *GS; const float* b_glu; bf16_t* CAT;
    __device__ __forceinline__ void operator()(const pg8::f32x4 (&acc)[2][2][4][2], const pg8::Unit& u, int wr, int wc, int fr, int fq) const {
        const int cbase = u.pn * 256 + wc * 32 + 8 * fq, rbase = u.pm * 256 + wr * 64 + fr;
#pragma unroll
        for (int bj = 0; bj < 2; ++bj) { const int c = cbase + 128 * bj;
            const f32x4 b0 = *(const GAS f32x4*)(b_glu + c), b1 = *(const GAS f32x4*)(b_glu + c + 4);
#pragma unroll
            for (int ai = 0; ai < 2; ++ai)
#pragma unroll
                for (int m = 0; m < 4; ++m) { const size_t r = (size_t)(rbase + 128 * ai + 16 * m);
                    const v4u y = *(const GAS v4u*)(YS + r * 512 + c), g = *(const GAS v4u*)(GS + r * 512 + c);
                    const f32x4 a0 = acc[ai][bj][m][0] + b0, a1 = acc[ai][bj][m][1] + b1;
                    v4u o;
                    o.x = pk2(bflo(y.x) * fast_sigmoid(a0.x) * bflo(g.x), bfhi(y.x) * fast_sigmoid(a0.y) * bfhi(g.x));
                    o.y = pk2(bflo(y.y) * fast_sigmoid(a0.z) * bflo(g.y), bfhi(y.y) * fast_sigmoid(a0.w) * bfhi(g.y));
                    o.z = pk2(bflo(y.z) * fast_sigmoid(a1.x) * bflo(g.z), bfhi(y.z) * fast_sigmoid(a1.y) * bfhi(g.z));
                    o.w = pk2(bflo(y.w) * fast_sigmoid(a1.z) * bflo(g.w), bfhi(y.w) * fast_sigmoid(a1.w) * bfhi(g.w));
                    *(GAS v4u*)(CAT + r * 1024 + 512 + c) = o; } }
    }
};
struct EpiOut {
    static constexpr bool PERM = false, AFTER_DRAIN = false;
    float* OUT;
    __device__ __forceinline__ void operator()(const pg8::f32x4 (&acc)[2][2][4][2], const pg8::Unit& u, int wr, int wc, int fr, int fq) const {
        const int cbase = u.pn * 256 + wc * 32 + 4 * fq, rbase = u.pm * 256 + wr * 64 + fr;
#pragma unroll
        for (int ai = 0; ai < 2; ++ai)
#pragma unroll
            for (int m = 0; m < 4; ++m) { float* o = OUT + (size_t)(rbase + 128 * ai + 16 * m) * 1024 + cbase;
#pragma unroll
                for (int bj = 0; bj < 2; ++bj) { *(GAS f32x4*)(o + 128 * bj) = acc[ai][bj][m][0]; *(GAS f32x4*)(o + 128 * bj + 16) = acc[ai][bj][m][1]; } }
    }
};
__device__ __forceinline__ void p6_final(Frame& F) {
    constexpr int RPB = NTOK / 256;
    const int row0 = blockIdx.x * RPB, ci0 = mod_index(row0), ci1 = mod_index(row0 + RPB - 1);
    LAS float* MODL = (LAS float*)F.lds;
    mod_to_lds(F, MODL, ci0, ci1, 2048, 1024);
    for (int m = row0 + F.wave; m < row0 + RPB; m += NWAVES) {
        const float* xr = m < NTOK_I ? F.x_prompt + (size_t)m * DM : F.x_sample + (size_t)(m - NTOK_I) * DM;
        const LAS float* gate = MODL + (mod_index(m) == ci0 ? 0 : 1024); const float* orow = F.OUT + (size_t)m * DM;
        f32x4 v[4]; float ss = 0.f;
#pragma unroll
        for (int j = 0; j < 4; ++j) { v[j] = ((const GAS f32x4*)orow)[F.lane + 64 * j]; ss += (v[j].x * v[j].x + v[j].y * v[j].y) + (v[j].z * v[j].z + v[j].w * v[j].w); }
        ss = wave_sum(ss); const float r = rsqrtf(ss * (1.f / DM) + EPS);
#pragma unroll
        for (int j = 0; j < 4; ++j) { const int i4 = F.lane + 64 * j;
            const f32x4 g = ((const GAS f32x4*)F.norm_post)[i4], ga = ((const LAS f32x4*)gate)[i4], x = ((const GAS f32x4*)xr)[i4];
            ((GAS f32x4*)(F.out + (size_t)m * DM))[i4] = x + ga * (v[j] * r) * g; }
    }
    __syncthreads();
}

__global__ void __launch_bounds__(NTHREADS, 2) mega(Args args) {
    extern __shared__ __attribute__((aligned(16))) unsigned char lds_raw[];
    Frame F;
    F.lds = (LAS unsigned char*)lds_raw; F.tid = threadIdx.x; F.lane = F.tid & 63; F.wave = __builtin_amdgcn_readfirstlane(F.tid >> 6); F.G = gridDim.x;
    volatile LAS unsigned* MISCL = (volatile LAS unsigned*)(F.lds + MISC_OFF);
    unsigned char* ws = args.ws;
    F.x_prompt = args.in[0]; F.x_sample = args.in[1]; F.cache_k = args.in[2]; F.cache_v = args.in[3]; F.state_ssm = args.in[4]; F.c = args.in[5]; F.c_ctx = args.in[6];
    F.w_ada = args.in[7]; F.b_ada = args.in[8]; F.norm_pre = args.in[9]; F.norm_post = args.in[10]; F.w_in = args.in[11]; F.lambda_qk = args.in[12]; F.subln = args.in[13];
    F.A_re = args.in[14]; F.A_im = args.in[15]; F.log_dt = args.in[16]; F.B_re = args.in[17]; F.B_im = args.in[18]; F.C_re = args.in[19]; F.C_im = args.in[20];
    F.ssm_D = args.in[21]; F.w_glu = args.in[22]; F.b_glu = args.in[23]; F.w_out = args.in[24]; F.out = args.out;
    F.PART = (float*)(ws + WS_MOD); F.MISC = (float*)(ws + WS_MISC); F.ROPE = (float*)(ws + WS_ROPE); F.OUT = (float*)(ws + WS_OUT);
    F.WIN = (bf16_t*)(ws + WS_WIN); F.WGLU = (bf16_t*)(ws + WS_WGLU); F.WOUT = (bf16_t*)(ws + WS_WOUT); F.XN = (bf16_t*)(ws + WS_XN); F.Q = (bf16_t*)(ws + WS_Q);
    F.KALL = (bf16_t*)(ws + WS_K); F.VALL = (bf16_t*)(ws + WS_V); F.GA = (bf16_t*)(ws + WS_GA); F.U = (bf16_t*)(ws + WS_U); F.GS = (bf16_t*)(ws + WS_GS);
    F.YS = (bf16_t*)(ws + WS_YS); F.CAT = (bf16_t*)(ws + WS_CAT); F.SSMW = (bf16_t*)(ws + WS_SSMW); F.SIDE = (float*)(ws + WS_SIDE);
    for (int u = F.tid; u < (LDS_BYTES - LDSCTL_OFF) / 4; u += NTHREADS) ((LAS unsigned*)(F.lds + LDSCTL_OFF))[u] = 0u;
    __syncthreads();
    const int lo = args.ph_lo, hi = args.ph_hi;
    XcdBarrier bar; bar.bar = (unsigned*)(ws + WS_CTL) + CW_BAR; bar.x = 0; bar.st = nullptr;
    bar = xcd_barrier_post((unsigned*)(ws + WS_CTL) + CW_BAR, MISCL + 8);
#define IN(k) (lo <= (k) && (k) < hi)
#define SEAM(k) do { if (IN(k) && IN((k) + 1)) xcd_barrier(bar); } while (0)

#define PH0(rp) { p0_prologue(F, (rp) == 0 ? 15 : args.p3mask); }
#define PH1(rp) { p1_prep_x(F); }
#define PH2(rp) { pg8::Gemm g{F.XN, F.WIN, NTOK, DIN, DM}; pg8::StaticOrder S; S.init(NTOK, DIN, F.G, (int)blockIdx.x); \
        EpiIn E{F.Q, F.KALL, F.VALL, F.GA, F.U, F.GS, F.out, F.ROPE}; \
        pg8::gemm_phase<EpiIn, pg8::StaticOrder, true, true>(F.lds, g, S, E); }
#ifdef SSM_PROBE
#define YS_DST (bf16_t*)F.OUT
#else
#define YS_DST F.YS
#endif
#define PH3(rp) { const int pm = (rp) == 0 ? 7 : args.p3mask; \
        const float lam = __uint_as_float(__hip_atomic_load((unsigned*)F.MISC, RLX_AGENT)); \
        const int bx = blockIdx.x, vcu = (F.G % 8 == 0) ? (bx % 8) * (F.G / 8) + bx / 8 : bx;     \
        for (int u0 = vcu; u0 < 512; u0 += F.G) { \
            int u = u0; \
            if (u0 >= 256) {                                     \
                if (u0 < 256 + 192) { const int it = u0 - 256, g = it / 6, sub = it % 6; \
                    if (pm & 2) ssm::item(g, sub < 4 ? 1 : 0, sub < 4 ? 2 * sub : 8 * (sub - 4), F.U, F.SSMW + (size_t)g * ssm::W_ELEMS, F.SIDE + g * ssm::SIDE_F32, F.state_ssm, YS_DST, F.out, F.lds); \
                    continue; } \
                u = 256 + 2 * (u0 - 448); \
                if (!(pm & 4)) continue; \
            } else if (!(pm & 1)) continue; \
            for (int rep = 0; rep < (u0 >= 256 ? 2 : 1); ++rep, ++u) { \
            int tok0, kbase, seq, h; \
            if (u < 256) { const int bh = u >> 3, b = bh >> 2; h = bh & 3; tok0 = NTOK_I + b * 1024 + (u & 7) * 128; kbase = 4096 + b * 1280; seq = 1280; } \
            else { const int s = u - 256, bh = s >> 1, b = bh >> 2; h = bh & 3; tok0 = b * 256 + (s & 1) * 128; kbase = b * 256; seq = 256; } \
            att::attn_unit(F.Q + (size_t)tok0 * 512 + h * 128, F.KALL + (size_t)kbase * 512 + h * 128, F.VALL + (size_t)kbase * 512 + h * 128, seq, (char*)lds_raw, lam, \
                           F.subln, F.GA + (size_t)tok0 * 512 + h * 128, F.CAT + (size_t)tok0 * 1024 + h * 128); \
            } \
        } }
#define PH4(rp) { pg8::Gemm g{F.YS, F.WGLU, NTOK, 512, 512}; pg8::StaticOrder S; S.init(NTOK, 512, F.G, (int)blockIdx.x); \
        EpiGlu E{F.YS, F.GS, F.b_glu, F.CAT}; \
        pg8::gemm_phase<EpiGlu, pg8::StaticOrder, true, true>(F.lds, g, S, E); }
#define PH5(rp) { pg8::Gemm g{F.CAT, F.WOUT, NTOK, DM, DM}; pg8::StaticOrder S; S.init(NTOK, DM, F.G, (int)blockIdx.x); \
        EpiOut E{F.OUT}; \
        pg8::gemm_phase<EpiOut, pg8::StaticOrder, true, true>(F.lds, g, S, E); }
#define PH6(rp) { p6_final(F); }
#ifdef DUP_PHASE
#define RUN(k, BODY) do { if (IN(k)) { BODY(0) if (DUP_PHASE == (k)) { xcd_barrier(bar); BODY(1) } } } while (0)
#else
#define RUN(k, BODY) do { if (IN(k)) { BODY(0) } } while (0)
#endif
    RUN(0, PH0); SEAM(0);
    RUN(1, PH1); SEAM(1);
    RUN(2, PH2); SEAM(2);
    RUN(3, PH3); SEAM(3);
    RUN(4, PH4); SEAM(4);
    RUN(5, PH5); SEAM(5);
    RUN(6, PH6);
#undef RUN
#undef IN
#undef SEAM
}
template <class Epi> __global__ void __launch_bounds__(256) k_gemm_naive(const bf16_t* A, const bf16_t* Bt, int M, int N, int K, Epi E) {
    __shared__ float As[16][65], Bs[16][65];
    const int tx = threadIdx.x & 15, ty = threadIdx.x >> 4, m0 = blockIdx.y * 64, n0 = blockIdx.x * 64;
    float acc[4][4];
#pragma unroll
    for (int i = 0; i < 4; ++i)
#pragma unroll
        for (int j = 0; j < 4; ++j) acc[i][j] = 0.f;
    for (int k0 = 0; k0 < K; k0 += 16) {
#pragma unroll
        for (int i = 0; i < 4; ++i) { const int e = threadIdx.x + 256 * i, r = e >> 4, kk = e & 15;
            As[kk][r] = bf2f(A[(size_t)(m0 + r) * K + k0 + kk]); Bs[kk][r] = bf2f(Bt[(size_t)(n0 + r) * K + k0 + kk]); }
        __syncthreads();
#pragma unroll
        for (int kk = 0; kk < 16; ++kk) { float a[4], b[4];
#pragma unroll
            for (int i = 0; i < 4; ++i) { a[i] = As[kk][ty + 16 * i]; b[i] = Bs[kk][tx + 16 * i]; }
#pragma unroll
            for (int i = 0; i < 4; ++i)
#pragma unroll
                for (int j = 0; j < 4; ++j) acc[i][j] += a[i] * b[j]; }
        __syncthreads();
    }
#pragma unroll
    for (int i = 0; i < 4; ++i) E(m0 + ty + 16 * i, n0, tx, acc[i]);
}
struct EpiInNaive {
    bf16_t *Q, *KALL, *VALL, *GA, *U, *GS; float* out; const float* ROPE;
    __device__ void operator()(int m, int n0, int tx, const float (&v)[4]) const {
        const int sec = n0 >> 9; float w[4] = {v[0], v[1], v[2], v[3]};
        if (sec < 2 && m >= NTOK_I) {
            const int t = (m - NTOK_I) & 1023, prow = t >> 6, pcol = t & 63;
            { const float c = ROPE[prow * 16 + tx], s = ROPE[1024 + prow * 16 + tx]; w[0] = v[0] * c - v[1] * s; w[1] = v[1] * c + v[0] * s; }
            { const float c = ROPE[pcol * 16 + tx], s = ROPE[1024 + pcol * 16 + tx]; w[2] = v[2] * c - v[3] * s; w[3] = v[3] * c + v[2] * s; }
        }
#pragma unroll
        for (int j = 0; j < 4; ++j) { const int cc = (n0 & 511) + tx + 16 * j; const float x = w[j];
            if (sec == 0) Q[(size_t)m * 512 + cc] = f2bf(x);
            else if (sec == 1) { KALL[(size_t)key_row(m) * 512 + cc] = f2bf(x); if (m < NTOK_I) out[O_NK + (size_t)m * 512 + cc] = x; }
            else if (sec == 2) { VALL[(size_t)key_row(m) * 512 + cc] = f2bf(x); if (m < NTOK_I) out[O_NV + (size_t)m * 512 + cc] = x; }
            else if (sec == 3) GA[(size_t)m * 512 + cc] = f2bf(siluf(x));
            else if (sec == 4) U[(size_t)m * 512 + cc] = f2bf(x);
            else GS[(size_t)m * 512 + cc] = f2bf(siluf(x)); }
    }
};
struct EpiGluNaive {
    const bf16_t *YS, *GS; const float* b_glu; bf16_t* CAT;
    __device__ void operator()(int m, int n0, int tx, const float (&v)[4]) const {
#pragma unroll
        for (int j = 0; j < 4; ++j) { const int n = n0 + tx + 16 * j; const float ys = bf2f(YS[(size_t)m * 512 + n]), gs = bf2f(GS[(size_t)m * 512 + n]);
            CAT[(size_t)m * 1024 + 512 + n] = f2bf(ys * sigmoidf(v[j] + b_glu[n]) * gs); }
    }
};
struct EpiOutNaive {
    float* OUT;
    __device__ void operator()(int m, int n0, int tx, const float (&v)[4]) const {
#pragma unroll
        for (int j = 0; j < 4; ++j) OUT[(size_t)m * 1024 + n0 + tx + 16 * j] = v[j];
    }
};

__global__ void __launch_bounds__(256) k_attn_naive(const bf16_t* Q, const bf16_t* KALL, const bf16_t* VALL, const bf16_t* GA, const float* subln, const float* MISC, bf16_t* CAT) {
    __shared__ float P[4][2][1280]; __shared__ float qs[4][128];
    const int h = threadIdx.x >> 6, lane = threadIdx.x & 63, m = blockIdx.x;
    const int kbase = m < NTOK_I ? (m >> 8) * 256 : 4096 + ((m - NTOK_I) >> 10) * 1280, nk = m < NTOK_I ? 256 : 1280;
    const float lam = MISC[0];
    qs[h][lane] = bf2f(Q[(size_t)m * 512 + h * 128 + lane]); qs[h][64 + lane] = bf2f(Q[(size_t)m * 512 + h * 128 + 64 + lane]);
    __syncthreads();
    float mx0 = -1e30f, mx1 = -1e30f;
    for (int kk = lane; kk < nk; kk += 64) { const bf16_t* kr = KALL + (size_t)(kbase + kk) * 512 + h * 128; float s0 = 0.f, s1 = 0.f;
        for (int d = 0; d < 64; ++d) { s0 += qs[h][d] * bf2f(kr[d]); s1 += qs[h][64 + d] * bf2f(kr[64 + d]); }
        s0 *= 0.125f; s1 *= 0.125f; P[h][0][kk] = s0; P[h][1][kk] = s1; mx0 = fmaxf(mx0, s0); mx1 = fmaxf(mx1, s1); }
    mx0 = wave_max(mx0); mx1 = wave_max(mx1);
    float l0 = 0.f, l1 = 0.f;
    for (int kk = lane; kk < nk; kk += 64) { const float p0 = expf(P[h][0][kk] - mx0), p1 = expf(P[h][1][kk] - mx1); P[h][0][kk] = p0; P[h][1][kk] = p1; l0 += p0; l1 += p1; }
    l0 = wave_sum(l0); l1 = wave_sum(l1);
    const float i0 = 1.f / l0, i1 = lam / l1;
    for (int kk = lane; kk < nk; kk += 64) P[h][0][kk] = P[h][0][kk] * i0 - P[h][1][kk] * i1;
    __syncthreads();
    float o0 = 0.f, o1 = 0.f;
    for (int kk = 0; kk < nk; ++kk) { const float w = P[h][0][kk]; const bf16_t* vr = VALL + (size_t)(kbase + kk) * 512 + h * 128; o0 += w * bf2f(vr[lane]); o1 += w * bf2f(vr[64 + lane]); }
    const float ss = wave_sum(o0 * o0 + o1 * o1), r = rsqrtf(ss * (1.f / 128.f) + EPS) * (1.f - LAM_INIT);
    const size_t gi = (size_t)m * 512 + h * 128;
    CAT[(size_t)m * 1024 + h * 128 + lane] = f2bf(o0 * r * subln[lane] * bf2f(GA[gi + lane]));
    CAT[(size_t)m * 1024 + h * 128 + 64 + lane] = f2bf(o1 * r * subln[64 + lane] * bf2f(GA[gi + 64 + lane]));
}

__global__ void __launch_bounds__(64) k_ssm_naive(const bf16_t* U, const float* A_re, const float* A_im, const float* log_dt, const float* B_re, const float* B_im,
                                                  const float* C_re, const float* C_im, const float* state_ssm, float* YF, float* YB, float* out) {
    const int ub = blockIdx.x >> 6, g = (blockIdx.x >> 1) & 31, d = blockIdx.x & 1, p = threadIdx.x;
    const int L = ub < 16 ? 256 : 1024; const size_t tok0 = ub < 16 ? (size_t)ub * 256 : 4096 + (size_t)(ub - 16) * 1024;
    const int dg = d * 32 + g;
    const float dt = expf(log_dt[dg]), Ar = A_re[dg * 64 + p], Ai = A_im[dg * 64 + p];
    const float mag = expf(Ar * dt), abr = mag * cosf(Ai * dt), abi = mag * sinf(Ai * dt);
    const float nr = abr - 1.f, ni = abi, den = Ar * Ar + Ai * Ai, fr = (nr * Ar + ni * Ai) / den, fi = (ni * Ar - nr * Ai) / den;
    float bbr[16], bbi[16], cr[16], ci[16];
#pragma unroll
    for (int h = 0; h < 16; ++h) { const float Br = B_re[(size_t)(dg * 64 + p) * 16 + h], Bi = B_im[(size_t)(dg * 64 + p) * 16 + h];
        bbr[h] = fr * Br - fi * Bi; bbi[h] = fr * Bi + fi * Br; cr[h] = C_re[(size_t)(dg * 16 + h) * 64 + p]; ci[h] = C_im[(size_t)(dg * 16 + h) * 64 + p]; }
    float hr = 0.f, hi = 0.f;
    if (ub >= 16) { const size_t sb = ((size_t)((ub - 16) * 2 + d) * 2) * 2048 + g * 64 + p; hr = state_ssm[sb]; hi = state_ssm[sb + 2048]; }
    float* Y = d == 0 ? YF : YB;
    for (int s = 0; s < L; ++s) { const int t = d == 0 ? s : L - 1 - s;
        const float uval = p < 16 ? bf2f(U[(tok0 + t) * 512 + g * 16 + p]) : 0.f;
        float bur = 0.f, bui = 0.f;
#pragma unroll
        for (int h = 0; h < 16; ++h) { const float uh = __shfl(uval, h); bur += bbr[h] * uh; bui += bbi[h] * uh; }
        const float nhr = abr * hr - abi * hi + bur, nhi = abr * hi + abi * hr + bui; hr = nhr; hi = nhi;
        float yout = 0.f;
#pragma unroll
        for (int hc = 0; hc < 16; ++hc) { const float v = wave_sum(cr[hc] * hr - ci[hc] * hi); if (p == hc) yout = v; }
        if (p < 16) Y[(tok0 + t) * 512 + g * 16 + p] = yout;
    }
    if (ub < 16) { const size_t sb = ((size_t)(ub * 2 + d) * 2) * 2048 + g * 64 + p; out[O_NS + sb] = hr; out[O_NS + sb + 2048] = hi; }
}
__global__ void __launch_bounds__(256) k_ys(const float* YF, const float* YB, const bf16_t* U, const float* Dskip, bf16_t* YS) {
    const size_t n = (size_t)NTOK * 512;
    for (size_t i = blockIdx.x * 256 + threadIdx.x; i < n; i += (size_t)gridDim.x * 256) YS[i] = f2bf(gelu_tanh(YF[i] + YB[i] + Dskip[i & 511] * bf2f(U[i])));
}
__global__ void __launch_bounds__(256) k_final(const float* xp, const float* xs, const float* OUT, const float* norm_post, const float* MOD, float* out) {
    const int gw = (blockIdx.x * 256 + threadIdx.x) >> 6, lane = threadIdx.x & 63, nw = (gridDim.x * 256) >> 6;
    for (int m = gw; m < NTOK; m += nw) {
        const float* xr = m < NTOK_I ? xp + (size_t)m * DM : xs + (size_t)(m - NTOK_I) * DM;
        const float* gate = MOD + mod_index(m) * DIN + 2 * DM; const float* orow = OUT + (size_t)m * DM;
        float4 v[4]; float ss = 0.f;
#pragma unroll
        for (int j = 0; j < 4; ++j) { v[j] = ((const float4*)orow)[lane + 64 * j]; ss += v[j].x * v[j].x + v[j].y * v[j].y + v[j].z * v[j].z + v[j].w * v[j].w; }
        ss = wave_sum(ss); const float r = rsqrtf(ss * (1.f / DM) + EPS);
#pragma unroll
        for (int j = 0; j < 4; ++j) { const int i4 = lane + 64 * j; const float4 g = ((const float4*)norm_post)[i4], ga = ((const float4*)gate)[i4], x = ((const float4*)xr)[i4];
            float4 o; o.x = x.x + ga.x * v[j].x * r * g.x; o.y = x.y + ga.y * v[j].y * r * g.y; o.z = x.z + ga.z * v[j].z * r * g.z; o.w = x.w + ga.w * v[j].w * r * g.w;
            ((float4*)(out + (size_t)m * DM))[i4] = o; }
    }
}


#ifdef SSM_PROBE
__global__ void __launch_bounds__(256) k_probe_cmp(const float* YO, const float* YF, const float* YB, float* acc) {
    float num = 0.f, den = 0.f; const size_t n = (size_t)NTOK * 512;
    for (size_t i = blockIdx.x * 256 + threadIdx.x; i < n; i += (size_t)gridDim.x * 256) { const float r = YF[i] + YB[i], d = YO[i] - r; num += d * d; den += r * r; }
    num = wave_sum(num); den = wave_sum(den);
    if ((threadIdx.x & 63) == 0) { atomicAdd(acc, num); atomicAdd(acc + 1, den); }
}
__global__ void __launch_bounds__(256) k_probe_poke(float* out, const float* acc) {
    const float f = 1.f + sqrtf(acc[0] / acc[1]);
    for (size_t i = blockIdx.x * 256 + threadIdx.x; i < 4194304; i += (size_t)gridDim.x * 256) out[i] *= f;
}
#endif
static void launch_mega(const Args& a0, int lo, int hi, int grid, hipStream_t stream) {
    Args a = a0; a.ph_lo = lo; a.ph_hi = hi;
    void* params[] = {&a};
    hipError_t e = hipLaunchCooperativeKernel((const void*)mega, dim3(grid), dim3(NTHREADS), params, LDS_BYTES, stream);
    if (e != hipSuccess) fprintf(stderr, "kernel_launch: cooperative launch [%d,%d) failed: %s (grid %d)\n", lo, hi, hipGetErrorString(e), grid);
}
extern "C" void kernel_launch(void* const* d_in, const int* in_sizes, int n_in, void* d_out, int out_size, void* d_ws, size_t ws_size, hipStream_t stream) {
    static int grid = 0;
    if (grid == 0) {
        if (n_in != 25 || ws_size < WS_END) { fprintf(stderr, "kernel_launch: unexpected n_in %d / ws %zu\n", n_in, ws_size); grid = -1; return; }
        int dev = 0, cus = 0, per_cu = 0;
        hipGetDevice(&dev); hipDeviceGetAttribute(&cus, hipDeviceAttributeMultiprocessorCount, dev);
        if (hipFuncSetAttribute((const void*)mega, hipFuncAttributeMaxDynamicSharedMemorySize, LDS_BYTES) != hipSuccess) { fprintf(stderr, "kernel_launch: hipFuncSetAttribute failed\n"); grid = -1; return; }
        hipOccupancyMaxActiveBlocksPerMultiprocessor(&per_cu, (const void*)mega, NTHREADS, LDS_BYTES);
        (void)hipGetLastError();
        if (per_cu < 1) fprintf(stderr, "kernel_launch: occupancy query reports %d blocks per CU\n", per_cu);
        grid = cus;
        if (grid != 256) { fprintf(stderr, "kernel_launch: built for a 256-CU device (work decomposition assumes a grid of 256), found %d CUs\n", cus); grid = -1; return; }
    }
    if (grid < 0) return;
    const float* x_prompt = (const float*)d_in[0]; const float* x_sample = (const float*)d_in[1];
    const float* state_ssm = (const float*)d_in[4];
    const float* norm_post = (const float*)d_in[10];
    const float* subln = (const float*)d_in[13]; const float* A_re = (const float*)d_in[14]; const float* A_im = (const float*)d_in[15];
    const float* log_dt = (const float*)d_in[16]; const float* B_re = (const float*)d_in[17]; const float* B_im = (const float*)d_in[18]; const float* C_re = (const float*)d_in[19];
    const float* C_im = (const float*)d_in[20]; const float* ssm_D = (const float*)d_in[21]; const float* b_glu = (const float*)d_in[23];
    float* out = (float*)d_out; char* ws = (char*)d_ws;
    float* MOD = (float*)(ws + WS_MOD); float* MISC = (float*)(ws + WS_MISC);
    bf16_t* WGLU = (bf16_t*)(ws + WS_WGLU); bf16_t* WOUT = (bf16_t*)(ws + WS_WOUT);
    bf16_t* Q = (bf16_t*)(ws + WS_Q); bf16_t* KALL = (bf16_t*)(ws + WS_K); bf16_t* VALL = (bf16_t*)(ws + WS_V);
    bf16_t* GA = (bf16_t*)(ws + WS_GA); bf16_t* U = (bf16_t*)(ws + WS_U); bf16_t* GS = (bf16_t*)(ws + WS_GS); bf16_t* YS = (bf16_t*)(ws + WS_YS);
    bf16_t* CAT = (bf16_t*)(ws + WS_CAT); float* OUT = (float*)(ws + WS_OUT); float* YF = (float*)(ws + WS_YF); float* YB = (float*)(ws + WS_YB);

    hipMemsetAsync(ws + WS_CTL, 0, CTL_ZERO_BYTES, stream);
    Args a{};
    for (int i = 0; i < 25; ++i) a.in[i] = (const float*)d_in[i];
    a.out = out; a.ws = (unsigned char*)d_ws;
    for (int k = 0; k < 8; ++k) a.rep[k] = 1;
    a.p3mask = 7;
#ifdef DUP_PHASE
#ifdef DUP_P3MASK
    a.p3mask = DUP_P3MASK;
#endif
#endif
#ifndef SSM_PROBE
    launch_mega(a, 0, 7, grid, stream);
#else
    launch_mega(a, 0, 2, grid, stream);
    launch_mega(a, 2, 3, grid, stream);
    launch_mega(a, 3, 4, grid, stream);
#ifdef SSM_PROBE
    k_ssm_naive<<<24 * 64, 64, 0, stream>>>(U, A_re, A_im, log_dt, B_re, B_im, C_re, C_im, state_ssm, YF, YB, out);
    k_ys<<<2048, 256, 0, stream>>>(YF, YB, U, ssm_D, YS);
    k_probe_cmp<<<1024, 256, 0, stream>>>(OUT, YF, YB, (float*)(ws + WS_CTL) + 60000);
#endif
    launch_mega(a, 4, 5, grid, stream);
    launch_mega(a, 5, 6, grid, stream);
    launch_mega(a, 6, 7, grid, stream);
    k_probe_poke<<<4096, 256, 0, stream>>>(out, (float*)(ws + WS_CTL) + 60000);
#endif
#ifdef SSM_PROBE_NEVER
    k_probe_poke<<<4096, 256, 0, stream>>>(out, (float*)(ws + WS_CTL) + 60000);
#endif
}
```

```cpp
#include <hip/hip_runtime.h>
#include <cstdint>
#include <cstdio>
#include <cmath>

typedef unsigned short bf16_t;
#define GAS __attribute__((address_space(1)))
#define LAS __attribute__((address_space(3)))
typedef unsigned v4u __attribute__((ext_vector_type(4)));
typedef unsigned v2u __attribute__((ext_vector_type(2)));
typedef float f32x4 __attribute__((ext_vector_type(4)));
typedef short bf16x8 __attribute__((ext_vector_type(8)));
typedef GAS unsigned gu32;
typedef GAS unsigned long long gu64;
#define RLX_AGENT __ATOMIC_RELAXED, __HIP_MEMORY_SCOPE_AGENT
#define LDS_WAIT() asm volatile("s_waitcnt lgkmcnt(0)" ::: "memory")
#define VM_WAIT() asm volatile("s_waitcnt vmcnt(0)" ::: "memory")
__device__ __forceinline__ unsigned f2bf(float f) { unsigned u = __builtin_bit_cast(unsigned, f); return (u + 0x7fffu + ((u >> 16) & 1u)) >> 16; }
__device__ __forceinline__ unsigned pk2(float lo, float hi) { return f2bf(lo) | (f2bf(hi) << 16); }
__device__ __forceinline__ float bf2f(bf16_t h) { return __uint_as_float(((unsigned)h) << 16); }
__device__ __forceinline__ float bflo(unsigned w) { return __uint_as_float(w << 16); }
__device__ __forceinline__ float bfhi(unsigned w) { return __uint_as_float(w & 0xffff0000u); }
__device__ __forceinline__ float wave_sum(float v) {
#pragma unroll
    for (int o = 1; o < 64; o <<= 1) v += __shfl_xor(v, o);
    return v;
}
__device__ __forceinline__ float wave_max(float v) {
#pragma unroll
    for (int o = 1; o < 64; o <<= 1) v = fmaxf(v, __shfl_xor(v, o));
    return v;
}
__device__ __forceinline__ float siluf(float x) { return x / (1.f + expf(-x)); }
__device__ __forceinline__ float sigmoidf(float x) { return 1.f / (1.f + expf(-x)); }
__device__ __forceinline__ float fast_sigmoid(float x) { return __builtin_amdgcn_rcpf(1.f + __builtin_amdgcn_exp2f(-1.4426950408889634f * x)); }
__device__ __forceinline__ float fast_silu(float x) { return x * fast_sigmoid(x); }
__device__ __forceinline__ float gelu_tanh(float x) { const float c = 0.7978845608028654f; return 0.5f * x * (1.f + tanhf(c * (x + 0.044715f * x * x * x))); }
__device__ __forceinline__ float fast_gelu_tanh(float x) { const float c2 = 1.5957691216057308f; return x * fast_sigmoid(c2 * (x + 0.044715f * x * x * x)); }

constexpr int DM = 1024, NTOK_I = 4096, NTOK = 12288, DIN = 3072;
constexpr int NKROWS = 4096 + 8 * 1280;
constexpr float EPS = 1e-6f, LAM_INIT = 0.2f;
constexpr size_t O_YP = 0, O_YS = 4194304, O_NK = 12582912, O_NV = 14680064, O_NS = 16777216;

constexpr size_t MiB = 1u << 20;
constexpr size_t WS_CTL = 0, CTL_ZERO_BYTES = 256 * 1024;
constexpr size_t WS_MOD = 1 * MiB + 128 * 1024;
constexpr size_t WS_MISC = 1 * MiB;
constexpr size_t WS_ROPE = WS_MISC + 1024;
constexpr size_t WS_WIN = 2 * MiB;
constexpr size_t WS_WGLU = 8 * MiB;
constexpr size_t WS_WOUT = 9 * MiB;
constexpr size_t WS_XN = 12 * MiB;
constexpr size_t WS_Q = 36 * MiB;
constexpr size_t WS_K = 48 * MiB;
constexpr size_t WS_V = 62 * MiB;
constexpr size_t WS_GA = 76 * MiB;
constexpr size_t WS_U = 88 * MiB;
constexpr size_t WS_GS = 100 * MiB;
constexpr size_t WS_YS = 112 * MiB;
constexpr size_t WS_CAT = 124 * MiB;
constexpr size_t WS_OUT = 148 * MiB;
constexpr size_t WS_YF = 196 * MiB;
constexpr size_t WS_YB = 220 * MiB;
constexpr size_t WS_SSMW = 244 * MiB;
constexpr size_t WS_SIDE = 1 * MiB + 64 * 1024;
constexpr size_t WS_END = 256 * MiB;
static_assert(WS_ROPE + 8192 <= WS_SIDE && WS_SIDE + 65536 <= WS_MOD && WS_MOD + 8 * 9 * 3072 * 4 <= WS_WIN, "small-table map");

__device__ __forceinline__ int mod_index(int m) { return m < NTOK_I ? 0 : 1 + ((m - NTOK_I) >> 10); }
__device__ __forceinline__ int key_row(int m) { return m < NTOK_I ? m : 4096 + ((m - NTOK_I) >> 10) * 1280 + 256 + ((m - NTOK_I) & 1023); }
namespace pg8 {
#define PG8_LAS __attribute__((address_space(3)))
typedef unsigned short bf16_t;
typedef short bf16x8 __attribute__((ext_vector_type(8)));
typedef float f32x4 __attribute__((ext_vector_type(4)));
typedef unsigned u32x4 __attribute__((ext_vector_type(4)));
constexpr int BM = 256, BK = 64, HALF = 128, HTB = HALF * BK * 2  , STAGE_BYTES = 8 * HTB, NXCD = 8, WGM = 8;

__host__ __device__ __forceinline__ int lds_byte(int r, int c) { const int st = (r >> 4) * 2 + (c >> 5), rr = r & 15, cc = c & 31, ob = rr * 64 + cc * 2; return st * 1024 + (ob ^ (((ob >> 9) & 1) << 5)); }
__host__ __device__ __forceinline__ void stage_rc(int b, int& R, int& C) { const int st = b / 1024, sb = b % 1024, swz = sb ^ (((sb >> 9) & 1) << 5); R = (st >> 1) * 16 + swz / 64; C = (st & 1) * 32 + (swz % 64) / 2; }
__host__ __device__ __forceinline__ int perm32(int rho) { const int n = rho >> 4, i = rho & 15; return 8 * (i >> 2) + 4 * n + (i & 3); }

struct Unit { int pm, pn; };
struct Gemm { const bf16_t* A; const bf16_t* Bt; int M, N, K; };

struct StaticOrder {
    int nM, nN, nwg, G, c;
    __host__ __device__ void init(int M, int N, int G_, int c_) { nM = M / BM; nN = N / BM; nwg = nM * nN; G = G_; c = c_; }
    __host__ __device__ bool next(int i, Unit& u) const {
        const long L = (long)i * G + c; if (L >= nwg) return false;
        int wgid = (int)L; { const int q = nwg / NXCD, r = nwg % NXCD, xcd = wgid % NXCD, off = wgid / NXCD; wgid = (xcd < r ? xcd * (q + 1) : r * (q + 1) + (xcd - r) * q) + off; }
        const int nig = WGM * nN, gid = wgid / nig, fm = gid * WGM, gsz = (nM - fm) < WGM ? (nM - fm) : WGM;
        u.pm = fm + ((wgid % nig) % gsz); u.pn = (wgid % nig) / gsz; return true;
    }
    __device__ __forceinline__ void a_ready(const Unit&) const {}
    __device__ __forceinline__ void done(const Unit&) const {}
};

__device__ __forceinline__ unsigned cvt_pk_bf16(float lo, float hi) { unsigned r; asm volatile("v_cvt_pk_bf16_f32 %0, %1, %2" : "=v"(r) : "v"(lo), "v"(hi)); return r; }
typedef float f32x2 __attribute__((ext_vector_type(2)));
template <class Epi, class Sched, bool ALIGN_EPI = false, bool SP2 = false>
__device__ __forceinline__ void gemm_phase(PG8_LAS unsigned char* lds, const Gemm g, const Sched& S, const Epi& E) {
    int tid_ = threadIdx.x; asm volatile("" : "+v"(tid_));
    const int tid = tid_, wid = __builtin_amdgcn_readfirstlane(tid >> 6), lane = tid & 63, wr = wid >> 2, wc = wid & 3, fr = lane & 15, fq = lane >> 4;
    const int K = g.K, nt = K / BK;
    unsigned voffA[2], voffB[2];
#pragma unroll
    for (int i = 0; i < 2; ++i) { int R, C; stage_rc(tid * 16 + i * 8192, R, C); const int Rb = Epi::PERM ? ((R & ~31) + perm32(R & 31)) : R;
        voffA[i] = (unsigned)(R * K + C) * 2u; voffB[i] = (unsigned)(Rb * K + C) * 2u; }
    const size_t kstep = (size_t)(BK * 2);
    const size_t hstep = (size_t)HALF * K * 2;
    const size_t tstep = 2 * hstep;
    const unsigned ldsw = (unsigned)wid * 1024u;
    const int aoff = lds_byte(wr * 64 + fr, fq * 8), boff = lds_byte(wc * 32 + fr, fq * 8);
#define PG8_SA(b, h) (((b) * 2 + (h)) * HTB)
#define PG8_SB(b, h) ((4 + (b) * 2 + (h)) * HTB)
#define PG8_STAGE(bufoff, gbase, voff) do { _Pragma("unroll") for (int _i = 0; _i < 2; ++_i) \
        __builtin_amdgcn_global_load_lds((const unsigned*)((const char*)(gbase) + (voff)[_i]), (PG8_LAS unsigned*)(lds + (bufoff) + ldsw + _i * 8192), 16, 0, 0); } while (0)
#define PG8_LDA(dst, b, h) do { _Pragma("unroll") for (int m = 0; m < 4; ++m) _Pragma("unroll") for (int k = 0; k < 2; ++k) dst[m][k] = *(const PG8_LAS bf16x8*)(lds + PG8_SA(b, h) + aoff + m * 2048 + k * 1024); } while (0)
#define PG8_LDB(dst, b, h) do { _Pragma("unroll") for (int n = 0; n < 2; ++n) _Pragma("unroll") for (int k = 0; k < 2; ++k) dst[n][k] = *(const PG8_LAS bf16x8*)(lds + PG8_SB(b, h) + boff + n * 2048 + k * 1024); } while (0)
#define PG8_MMA(ai, bj, At, Bt) do { __builtin_amdgcn_s_setprio(1); _Pragma("unroll") for (int m = 0; m < 4; ++m) _Pragma("unroll") for (int n = 0; n < 2; ++n) _Pragma("unroll") for (int k = 0; k < 2; ++k) \
        acc[ai][bj][m][n] = __builtin_amdgcn_mfma_f32_16x16x32_bf16(Bt[n][k], At[m][k], acc[ai][bj][m][n], 0, 0, 0); __builtin_amdgcn_s_setprio(0); } while (0)
#define PG8_WAIT_V(n) asm volatile("s_waitcnt vmcnt(" #n ")" ::: "memory")
#define PG8_WAIT_L(n) asm volatile("s_waitcnt lgkmcnt(" #n ")" ::: "memory")
#define PG8_BAR __builtin_amdgcn_s_barrier()
#define PG8_SCHED __builtin_amdgcn_sched_barrier(0)
    Unit cur, nxt; int ui = 0;
    if (!S.next(0, cur)) return;
    f32x4 acc[2][2][4][2];
#pragma unroll
    for (int a = 0; a < 2; ++a)
#pragma unroll
        for (int b = 0; b < 2; ++b)
#pragma unroll
            for (int m = 0; m < 4; ++m)
#pragma unroll
                for (int n = 0; n < 2; ++n) acc[a][b][m][n] = (f32x4){0.f, 0.f, 0.f, 0.f};
    bf16x8 At[4][2], B0[2][2], B1[2][2];
    const char* cA = (const char*)g.A + (size_t)cur.pm * tstep; const char* cB = (const char*)g.Bt + (size_t)cur.pn * tstep;
    S.a_ready(cur);
    if constexpr (SP2) {
        PG8_STAGE(PG8_SB(0, 0), cB, voffB); PG8_STAGE(PG8_SB(0, 1), cB + hstep, voffB); PG8_STAGE(PG8_SA(0, 0), cA, voffA); PG8_STAGE(PG8_SA(0, 1), cA + hstep, voffA);
        if (wr == 1) PG8_BAR;
        PG8_WAIT_V(2); PG8_BAR;
        PG8_STAGE(PG8_SB(1, 0), cB + kstep, voffB); PG8_STAGE(PG8_SA(1, 0), cA + kstep, voffA); PG8_STAGE(PG8_SB(1, 1), cB + hstep + kstep, voffB);
        PG8_WAIT_V(6); PG8_BAR;
    } else {
        PG8_STAGE(PG8_SB(0, 0), cB, voffB); PG8_STAGE(PG8_SA(0, 0), cA, voffA); PG8_STAGE(PG8_SB(0, 1), cB + hstep, voffB); PG8_STAGE(PG8_SA(0, 1), cA + hstep, voffA);
        if (wr == 1) PG8_BAR;
        PG8_WAIT_V(4); PG8_BAR;
        PG8_STAGE(PG8_SB(1, 0), cB + kstep, voffB); PG8_STAGE(PG8_SA(1, 0), cA + kstep, voffA); PG8_STAGE(PG8_SB(1, 1), cB + hstep + kstep, voffB);
        PG8_WAIT_V(6); PG8_BAR;
    }
    for (;;) {
        const bool has_next = S.next(ui + 1, nxt);
        const char* nA = has_next ? (const char*)g.A + (size_t)nxt.pm * tstep : cA; const char* nB = has_next ? (const char*)g.Bt + (size_t)nxt.pn * tstep : cB;
        for (int t = 0; t < nt; t += 2) {
            const bool last = (t == nt - 2);
            const char* a1 = cA + (size_t)(t + 1) * kstep;
            const char* a2 = last ? nA : cA + (size_t)(t + 2) * kstep; const char* b2 = last ? nB : cB + (size_t)(t + 2) * kstep;
            const char* a3 = a2 + kstep; const char* b3 = b2 + kstep;
            if (last && has_next) S.a_ready(nxt);
            if constexpr (SP2) {
            PG8_LDB(B0, 0, 0); PG8_LDB(B1, 0, 1); PG8_SCHED; PG8_LDA(At, 0, 0); PG8_STAGE(PG8_SA(1, 1), a1 + hstep, voffA);
            PG8_WAIT_V(8); PG8_WAIT_L(0); PG8_BAR; PG8_MMA(0, 0, At, B0); PG8_MMA(0, 1, At, B1); PG8_BAR; PG8_SCHED;
            PG8_LDA(At, 0, 1); PG8_STAGE(PG8_SB(0, 0), b2, voffB); PG8_STAGE(PG8_SB(0, 1), b2 + hstep, voffB); PG8_STAGE(PG8_SA(0, 0), a2, voffA);
            PG8_WAIT_V(8); PG8_WAIT_L(0); PG8_BAR; PG8_MMA(1, 0, At, B0); PG8_MMA(1, 1, At, B1); PG8_BAR; PG8_SCHED;
            PG8_LDB(B0, 1, 0); PG8_LDB(B1, 1, 1); PG8_SCHED; PG8_LDA(At, 1, 0); PG8_STAGE(PG8_SA(0, 1), a2 + hstep, voffA);
            PG8_WAIT_V(8); PG8_WAIT_L(0); PG8_BAR; PG8_MMA(0, 0, At, B0); PG8_MMA(0, 1, At, B1); PG8_BAR; PG8_SCHED;
            PG8_LDA(At, 1, 1); PG8_STAGE(PG8_SB(1, 0), b3, voffB); PG8_STAGE(PG8_SB(1, 1), b3 + hstep, voffB); PG8_STAGE(PG8_SA(1, 0), a3, voffA);
            PG8_WAIT_V(8); PG8_WAIT_L(0); PG8_BAR; PG8_MMA(1, 0, At, B0); PG8_MMA(1, 1, At, B1); PG8_BAR; PG8_SCHED;
            } else {
            PG8_LDB(B0, 0, 0); PG8_SCHED; PG8_LDA(At, 0, 0); PG8_STAGE(PG8_SA(1, 1), a1 + hstep, voffA);
            PG8_WAIT_L(8); PG8_BAR; PG8_WAIT_L(0); PG8_MMA(0, 0, At, B0); PG8_BAR; PG8_SCHED;
            PG8_LDB(B1, 0, 1); PG8_STAGE(PG8_SB(0, 0), b2, voffB);
            PG8_BAR; PG8_WAIT_L(0); PG8_MMA(0, 1, At, B1); PG8_BAR;
            PG8_LDA(At, 0, 1); PG8_STAGE(PG8_SA(0, 0), a2, voffA);
            PG8_BAR; PG8_WAIT_L(0); PG8_MMA(1, 0, At, B0); PG8_BAR; PG8_SCHED;
            PG8_STAGE(PG8_SB(0, 1), b2 + hstep, voffB);
            PG8_WAIT_V(6); PG8_BAR; PG8_MMA(1, 1, At, B1); PG8_BAR;
            PG8_LDB(B0, 1, 0); PG8_SCHED; PG8_LDA(At, 1, 0); PG8_STAGE(PG8_SA(0, 1), a2 + hstep, voffA);
            PG8_WAIT_L(8); PG8_BAR; PG8_WAIT_L(0); PG8_MMA(0, 0, At, B0); PG8_BAR; PG8_SCHED;
            PG8_LDB(B1, 1, 1); PG8_STAGE(PG8_SB(1, 0), b3, voffB);
            PG8_BAR; PG8_WAIT_L(0); PG8_MMA(0, 1, At, B1); PG8_BAR;
            PG8_LDA(At, 1, 1); PG8_STAGE(PG8_SA(1, 0), a3, voffA);
            PG8_BAR; PG8_WAIT_L(0); PG8_MMA(1, 0, At, B0); PG8_BAR; PG8_SCHED;
            PG8_STAGE(PG8_SB(1, 1), b3 + hstep, voffB);
            PG8_WAIT_V(6); PG8_BAR; PG8_MMA(1, 1, At, B1); PG8_BAR;
            }
        }
        if constexpr (ALIGN_EPI) { if (wr == 0) PG8_BAR; }
        if constexpr (!Epi::AFTER_DRAIN) { E(acc, cur, wr, wc, fr, fq); S.done(cur); }
        if (!has_next) break;
#pragma unroll
        for (int a = 0; a < 2; ++a)
#pragma unroll
            for (int b = 0; b < 2; ++b)
#pragma unroll
                for (int m = 0; m < 4; ++m)
#pragma unroll
                    for (int n = 0; n < 2; ++n) acc[a][b][m][n] = (f32x4){0.f, 0.f, 0.f, 0.f};
        cur = nxt; cA = nA; cB = nB; ++ui;
        if constexpr (ALIGN_EPI) { if (wr == 1) PG8_BAR; }
    }
    PG8_WAIT_V(0);
    if constexpr (!ALIGN_EPI) { if (wr == 0) PG8_BAR; }
    PG8_BAR;
    if constexpr (Epi::AFTER_DRAIN) { E.fused(acc, cur, wr, wc, fr, fq, lds, wid, lane); S.done(cur); }
#undef PG8_SA
#undef PG8_SB
#undef PG8_STAGE
#undef PG8_LDA
#undef PG8_LDB
#undef PG8_MMA
#undef PG8_WAIT_V
#undef PG8_WAIT_L
#undef PG8_BAR
#undef PG8_SCHED
}
}
#define XB_TMO      128
#define XB_XCNT(j)  (256  + 64 * (j))
#define XB_XSUB(j)  (1280 + 64 * (j))
#define XB_XGEN(j)  (2304 + 64 * (j))
#define XB_TOP      3328
#define XB_TOPGEN   3392
#define XCD_BAR_WORDS 3456
#define XB_SPIN_CAP (1u << 18)

__device__ __forceinline__ unsigned xb_ld(unsigned* p)              { return __hip_atomic_load(p, __ATOMIC_RELAXED, __HIP_MEMORY_SCOPE_AGENT); }
__device__ __forceinline__ unsigned xb_add(unsigned* p, unsigned v) { return __hip_atomic_fetch_add(p, v, __ATOMIC_RELAXED, __HIP_MEMORY_SCOPE_AGENT); }
__device__ __forceinline__ unsigned xb_xcc_id() { return (unsigned)__builtin_amdgcn_s_getreg((3 << 11) | 20) & 0xFu; }
#define XB_SPIN(cond, bar) do { unsigned _sp = 0; while (cond) { __builtin_amdgcn_s_sleep(1); \
    if ((++_sp & 255u) == 0u) { if (xb_ld(&(bar)[XB_TMO])) break; if (_sp > XB_SPIN_CAP) { atomicAdd(&(bar)[XB_TMO], 1u); break; } } } } while (0)

struct XcdBarrier {
    unsigned* bar; unsigned x;
    volatile LAS unsigned* st;
};

__device__ __forceinline__ XcdBarrier xcd_barrier_post(unsigned* bar, volatile LAS unsigned* st) {
    XcdBarrier b; b.bar = bar; b.x = xb_xcc_id(); b.st = st;
    if (threadIdx.x == 0) (void)xb_add(&bar[XB_XCNT(b.x)], 1u);
    return b;
}
__device__ __forceinline__ void xcd_barrier_complete(unsigned* bar, unsigned x, unsigned& nloc, unsigned& nx) {
    const unsigned G = gridDim.x * gridDim.y * gridDim.z;
    unsigned sum, cnt, mine, sp = 0u;
    for (;;) {
        sum = 0u; cnt = 0u; mine = 0u;
#pragma unroll
        for (unsigned j = 0; j < 16; ++j) { const unsigned c = xb_ld(&bar[XB_XCNT(j)]); sum += c; cnt += (c > 0u) ? 1u : 0u; mine = (j == x) ? c : mine; }
        if (sum == G) break;
        __builtin_amdgcn_s_sleep(1);
        if ((++sp & 255u) == 0u) { if (xb_ld(&bar[XB_TMO])) break; if (sp > XB_SPIN_CAP) { atomicAdd(&bar[XB_TMO], 1u); break; } }
    }
    nloc = mine > 0u ? mine : 1u; nx = cnt > 0u ? cnt : 1u;
}

__device__ __forceinline__ void xcd_barrier(const XcdBarrier& b) {
    asm volatile("s_waitcnt vmcnt(0)" ::: "memory");
    __syncthreads();
    if (threadIdx.x == 0) {
        unsigned* bar = b.bar;
        __builtin_amdgcn_s_waitcnt(0);
        unsigned nloc = b.st[0], nx = b.st[1];
        if (nloc == 0u) { xcd_barrier_complete(bar, b.x, nloc, nx); b.st[0] = nloc; b.st[1] = nx; }
        const unsigned old = xb_add(&bar[XB_XSUB(b.x)], 1u);
        const unsigned gen = old / nloc;
        if (old + 1u == (gen + 1u) * nloc) {
            __builtin_amdgcn_fence(__ATOMIC_RELEASE, "agent");
            asm volatile("s_waitcnt vmcnt(0)" ::: "memory");
            const unsigned og = xb_add(&bar[XB_TOP], 1u);
            const unsigned tg = og / nx;
            if (og + 1u == (tg + 1u) * nx) xb_add(&bar[XB_TOPGEN], 1u);
            else XB_SPIN(xb_ld(&bar[XB_TOPGEN]) == tg, bar);
            __builtin_amdgcn_fence(__ATOMIC_ACQUIRE, "agent");
            xb_add(&bar[XB_XGEN(b.x)], 1u);
            asm volatile("s_waitcnt vmcnt(0)" ::: "memory");
        } else {
            XB_SPIN(xb_ld(&bar[XB_XGEN(b.x)]) == gen, bar);
            __builtin_amdgcn_fence(__ATOMIC_ACQUIRE, "agent");
            asm volatile("s_waitcnt vmcnt(0)" ::: "memory");
        }
    }
    __syncthreads();
}

namespace att {
using s16x4  = __attribute__((ext_vector_type(4))) short;
using f32x16 = __attribute__((ext_vector_type(16))) float;
using u32x4  = __attribute__((ext_vector_type(4))) unsigned;
constexpr int QBLK = 32, KVBLK = 64, LDK = 512, LDQ = 512;
constexpr float SCALE = 0.125f, THR = 8.f;
constexpr size_t SHM_V = KVBLK * 128 * 2, SHM_K = KVBLK * 128 * 2, SHM_ATTN = 2 * SHM_V + 2 * SHM_K + 8 * 64 * 4;
#define KSWZ(row, colB) ((row) * 256 + ((colB) ^ (((row) & 7) << 4)))
#define SBAR() __builtin_amdgcn_sched_barrier(0)
__device__ __forceinline__ int crow(int r, int hi) { return (r & 3) + 8 * (r >> 2) + 4 * hi; }
__device__ __forceinline__ unsigned cvtpk(float lo, float hi) { unsigned r; asm volatile("v_cvt_pk_bf16_f32 %0, %1, %2" : "=v"(r) : "v"(lo), "v"(hi)); return r; }
__device__ __forceinline__ bf16x8 ld8(const bf16_t* p) { return *reinterpret_cast<const bf16x8*>(p); }

__device__ __forceinline__ void partialSM(f32x16& p0, f32x16& p1, float& m_reg, float& mn, float& alpha) {
  constexpr float C = SCALE * 1.4426950408889634f;
  float pmax = p0[0]; for (int r = 1; r < 16; ++r) pmax = fmaxf(pmax, p0[r]); for (int r = 0; r < 16; ++r) pmax = fmaxf(pmax, p1[r]);
  { auto rr = __builtin_amdgcn_permlane32_swap(__float_as_uint(pmax), __float_as_uint(pmax), false, false);
    pmax = fmaxf(__uint_as_float(rr[0]), __uint_as_float(rr[1])); }
  if (__builtin_expect(__all(pmax - m_reg <= THR / SCALE), 1)) { mn = m_reg; alpha = 1.f; }
  else { mn = fmaxf(m_reg, pmax); alpha = __builtin_amdgcn_exp2f((m_reg - mn) * C); m_reg = mn; }
  float mnC = -mn * C;
  for (int r = 0; r < 16; ++r) p0[r] = fmaf(p0[r], C, mnC); for (int r = 0; r < 16; ++r) p1[r] = fmaf(p1[r], C, mnC);
  for (int r = 0; r < 16; ++r) p0[r] = __builtin_amdgcn_exp2f(p0[r]);
}
__device__ __forceinline__ void finishSM(f32x16& p0, f32x16& p1, float alpha, float& l_reg, bf16x8& pa0, bf16x8& pa1, bf16x8& pa2, bf16x8& pa3) {
  for (int r = 0; r < 16; ++r) p1[r] = __builtin_amdgcn_exp2f(p1[r]);
  float ps = 0; for (int r = 0; r < 16; ++r) ps += p0[r]; for (int r = 0; r < 16; ++r) ps += p1[r];
  { auto rr = __builtin_amdgcn_permlane32_swap(__float_as_uint(ps), __float_as_uint(ps), false, false);
    ps = __uint_as_float(rr[0]) + __uint_as_float(rr[1]); }
  l_reg = l_reg * alpha + ps;
#define PK4(P, BASE, OUT) do { unsigned a0 = cvtpk(P[BASE + 0], P[BASE + 1]), a1 = cvtpk(P[BASE + 2], P[BASE + 3]);   \
    unsigned b0 = cvtpk(P[BASE + 4], P[BASE + 5]), b1 = cvtpk(P[BASE + 6], P[BASE + 7]);                              \
    auto r0 = __builtin_amdgcn_permlane32_swap(a0, b0, false, false); auto r1 = __builtin_amdgcn_permlane32_swap(a1, b1, false, false); \
    u32x4 w = {r0[0], r1[0], r0[1], r1[1]}; OUT = *reinterpret_cast<bf16x8*>(&w); } while (0)
  PK4(p0, 0, pa0); PK4(p0, 8, pa1); PK4(p1, 0, pa2); PK4(p1, 8, pa3);
#undef PK4
}
__device__ __forceinline__ void qkt(f32x16& p0, f32x16& p1, const bf16_t* Ks, const bf16x8* qr, int r32, int hi, int c) {
  p0 = f32x16{}; p1 = f32x16{};
#pragma unroll
  for (int d0 = 0; d0 < 4; ++d0) { int cb = (c * 64 + d0 * 16 + hi * 8) * 2;
    bf16x8 b0 = *reinterpret_cast<const bf16x8*>((const char*)Ks + KSWZ(r32, cb));
    bf16x8 b1 = *reinterpret_cast<const bf16x8*>((const char*)Ks + KSWZ(32 + r32, cb));
    p0 = __builtin_amdgcn_mfma_f32_32x32x16_bf16(b0, qr[d0], p0, 0, 0, 0);
    p1 = __builtin_amdgcn_mfma_f32_32x32x16_bf16(b1, qr[d0], p1, 0, 0, 0); }
}
__device__ __forceinline__ int v_st(int k, int c) { const int kk = (k & ~0xC) | ((k & 4) << 1) | ((k & 8) >> 1); return ((kk >> 3) * 4 + (c >> 5)) * 512 + ((kk & 7) * 32 + (c & 31)) * 2; }
__device__ __forceinline__ int v_rd_base(int lane) { return ((lane & 3) << 3) | (((lane >> 2) & 3) << 6) | (((lane >> 4) & 1) << 5) | (((lane >> 5) & 1) << 8); }
constexpr int v_rd_off(int d0, int ks, int half) { return d0 * 512 + ks * 4096 + half * 2048; }
template <int OFF> __device__ __forceinline__ s16x4 tr_read(int vb) {
  s16x4 r; asm volatile("ds_read_b64_tr_b16 %0, %1 offset:%2" : "=&v"(r) : "v"(vb), "i"(OFF) : "memory"); return r;
}
template <int D0> __device__ __forceinline__ void pv_one(f32x16& od, int vb, bf16x8 pa0, bf16x8 pa1, bf16x8 pa2, bf16x8 pa3) {
  const s16x4 l0 = tr_read<v_rd_off(D0, 0, 0)>(vb), h0 = tr_read<v_rd_off(D0, 0, 1)>(vb), l1 = tr_read<v_rd_off(D0, 1, 0)>(vb), h1 = tr_read<v_rd_off(D0, 1, 1)>(vb);
  const s16x4 l2 = tr_read<v_rd_off(D0, 2, 0)>(vb), h2 = tr_read<v_rd_off(D0, 2, 1)>(vb), l3 = tr_read<v_rd_off(D0, 3, 0)>(vb), h3 = tr_read<v_rd_off(D0, 3, 1)>(vb);
  asm volatile("s_waitcnt lgkmcnt(0)" ::: "memory"); SBAR();
#define PK(L, H) (bf16x8){L[0], L[1], L[2], L[3], H[0], H[1], H[2], H[3]}
  od = __builtin_amdgcn_mfma_f32_32x32x16_bf16(pa0, PK(l0, h0), od, 0, 0, 0);
  od = __builtin_amdgcn_mfma_f32_32x32x16_bf16(pa1, PK(l1, h1), od, 0, 0, 0);
  od = __builtin_amdgcn_mfma_f32_32x32x16_bf16(pa2, PK(l2, h2), od, 0, 0, 0);
  od = __builtin_amdgcn_mfma_f32_32x32x16_bf16(pa3, PK(l3, h3), od, 0, 0, 0);
#undef PK
}
__device__ __forceinline__ void pv_d0(f32x16* o, int vb, bf16x8 pa0, bf16x8 pa1, bf16x8 pa2, bf16x8 pa3) {
  pv_one<0>(o[0], vb, pa0, pa1, pa2, pa3); pv_one<1>(o[1], vb, pa0, pa1, pa2, pa3); pv_one<2>(o[2], vb, pa0, pa1, pa2, pa3); pv_one<3>(o[3], vb, pa0, pa1, pa2, pa3);
}

__device__ __forceinline__ void attn_unit(const bf16_t* Qb, const bf16_t* Kh, const bf16_t* Vh, int seq, char* lds, float lam, const float* subln, const bf16_t* GAb, bf16_t* CATb) {
  int tid_ = threadIdx.x; asm volatile("" : "+v"(tid_));
  const int tid = tid_, wid = __builtin_amdgcn_readfirstlane(tid >> 6), lane = tid & 63, r32 = lane & 31, hi = lane >> 5, c = wid >> 2, wq = wid & 3;
  bf16_t* V_lds = (bf16_t*)lds; bf16_t* K_lds = (bf16_t*)(lds + 2 * SHM_V);
  float* ws = (float*)(lds + 2 * SHM_V + 2 * SHM_K) + wid * 64; float* li_l = ws; float* al_l = ws + 32;
  float m_reg = -1e30f, l_reg = 0; f32x16 o[4] = {}; bf16x8 qr[4];
  const bf16_t* Qw = Qb + (long)(wq * QBLK + r32) * LDQ + c * 64 + hi * 8;
#pragma unroll
  for (int d0 = 0; d0 < 4; ++d0) qr[d0] = ld8(Qw + d0 * 16);
  const int sr = tid >> 4, sc = (tid & 15) * 8, vst0 = v_st(sr, sc), vst1 = v_st(32 + sr, sc);
  const int vb0 = (int)(uintptr_t)V_lds + v_rd_base(lane);
  struct { bf16x8 vs0, vs1, ks0, ks1; } sr_[2];
#define SLOAD(i, k0) do { sr_[i].vs0 = ld8(&Vh[(long)((k0) + sr) * LDK + sc]); sr_[i].vs1 = ld8(&Vh[(long)((k0) + 32 + sr) * LDK + sc]); \
    sr_[i].ks0 = ld8(&Kh[(long)((k0) + sr) * LDK + sc]); sr_[i].ks1 = ld8(&Kh[(long)((k0) + 32 + sr) * LDK + sc]); } while (0)
#define SWRITE(b, i) do { *(bf16x8*)((char*)V_lds + (b) * SHM_V + vst0) = sr_[i].vs0;          \
    *(bf16x8*)((char*)V_lds + (b) * SHM_V + vst1) = sr_[i].vs1; int kc = sc * 2;               \
    *(bf16x8*)((char*)K_lds + (b) * SHM_K + KSWZ(sr, kc)) = sr_[i].ks0;                       \
    *(bf16x8*)((char*)K_lds + (b) * SHM_K + KSWZ(32 + sr, kc)) = sr_[i].ks1; } while (0)
#define SWAIT() asm volatile("s_waitcnt vmcnt(4)" ::: "memory")
#define RESC(a) do { if (__any((a) < 1.f)) { if (hi == 0) al_l[r32] = (a); asm volatile("s_waitcnt lgkmcnt(0)" ::: "memory"); \
    for (int d = 0; d < 4; ++d) for (int r = 0; r < 16; ++r) o[d][r] *= al_l[crow(r, hi)]; } } while (0)
  f32x16 pA0, pA1, pB0, pB1; float mnA, mnB, alA, alB; bf16x8 pa0, pa1, pa2, pa3; const int NT = seq / KVBLK;
  constexpr int SE = 0, SO = 1;
  SLOAD(SE, 0); asm volatile("s_waitcnt vmcnt(0)" ::: "memory"); SWRITE(0, SE); __syncthreads();
  qkt(pA0, pA1, K_lds, qr, r32, hi, c); partialSM(pA0, pA1, m_reg, mnA, alA);
  SLOAD(SO, KVBLK); if (2 < NT) SLOAD(SE, 2 * KVBLK);
  SWAIT(); SWRITE(1, SO); __syncthreads();
  for (int j = 1; j + 1 < NT; j += 2) {
    SBAR(); qkt(pB0, pB1, (bf16_t*)((char*)K_lds + SHM_K), qr, r32, hi, c);
    finishSM(pA0, pA1, alA, l_reg, pa0, pa1, pa2, pa3); SBAR();
    SLOAD(SO, (j + 2) * KVBLK); SBAR();
    pv_d0(o, vb0, pa0, pa1, pa2, pa3); partialSM(pB0, pB1, m_reg, mnB, alB);
    __syncthreads(); SWAIT(); SWRITE(0, SE);
    RESC(alB); __syncthreads();
    SBAR(); qkt(pA0, pA1, K_lds, qr, r32, hi, c);
    finishSM(pB0, pB1, alB, l_reg, pa0, pa1, pa2, pa3); SBAR();
    if (j + 3 < NT) SLOAD(SE, (j + 3) * KVBLK); SBAR();
    pv_d0(o, vb0 + (int)SHM_V, pa0, pa1, pa2, pa3); partialSM(pA0, pA1, m_reg, mnA, alA);
    __syncthreads(); SWAIT(); SWRITE(1, SO);
    RESC(alA); __syncthreads();
  }
  SBAR(); qkt(pB0, pB1, (bf16_t*)((char*)K_lds + SHM_K), qr, r32, hi, c);
  finishSM(pA0, pA1, alA, l_reg, pa0, pa1, pa2, pa3); SBAR();
  pv_d0(o, vb0, pa0, pa1, pa2, pa3); partialSM(pB0, pB1, m_reg, mnB, alB);
  __syncthreads(); RESC(alB);
  finishSM(pB0, pB1, alB, l_reg, pa0, pa1, pa2, pa3); SBAR();
  pv_d0(o, vb0 + (int)SHM_V, pa0, pa1, pa2, pa3);
  if (hi == 0) li_l[r32] = l_reg; asm volatile("s_waitcnt lgkmcnt(0)" ::: "memory");
  float rli[16];
#pragma unroll
  for (int r = 0; r < 16; ++r) rli[r] = __builtin_amdgcn_rcpf(li_l[crow(r, hi)]);
  __syncthreads();
  float* X = (float*)lds + (size_t)wq * (32 * 128);
  if (c == 1) {
#pragma unroll
    for (int r = 0; r < 16; ++r) { const int orow = crow(r, hi); const float f = rli[r] * lam;
#pragma unroll
      for (int d0 = 0; d0 < 4; ++d0) X[orow * 128 + d0 * 32 + r32] = o[d0][r] * f; }
  }
  __syncthreads();
  if (c == 0) {
#pragma unroll
    for (int r = 0; r < 16; ++r) { const int orow = crow(r, hi); float v[4]; float ss = 0.f;
#pragma unroll
      for (int d0 = 0; d0 < 4; ++d0) { v[d0] = o[d0][r] * rli[r] - X[orow * 128 + d0 * 32 + r32]; ss += v[d0] * v[d0]; }
#pragma unroll
      for (int s = 1; s < 32; s <<= 1) ss += __shfl_xor(ss, s);
      const float rs = rsqrtf(ss * (1.f / 128.f) + EPS) * (1.f - LAM_INIT);
#pragma unroll
      for (int d0 = 0; d0 < 4; ++d0) X[orow * 128 + d0 * 32 + r32] = v[d0] * rs; }
    asm volatile("s_waitcnt lgkmcnt(0)" ::: "memory");
    const int ch = lane & 15; float sg[8];
#pragma unroll
    for (int e = 0; e < 8; ++e) sg[e] = subln[ch * 8 + e];
#pragma unroll
    for (int it = 0; it < 8; ++it) { const int row = it * 4 + (lane >> 4); const long grow = (long)(wq * QBLK + row);
      const f32x4 x0 = *(const f32x4*)(X + row * 128 + ch * 8), x1 = *(const f32x4*)(X + row * 128 + ch * 8 + 4);
      const v4u g = *(const v4u*)(GAb + grow * 512 + ch * 8);
      v4u w; w.x = pk2(x0.x * sg[0] * bflo(g.x), x0.y * sg[1] * bfhi(g.x)); w.y = pk2(x0.z * sg[2] * bflo(g.y), x0.w * sg[3] * bfhi(g.y));
      w.z = pk2(x1.x * sg[4] * bflo(g.z), x1.y * sg[5] * bfhi(g.z)); w.w = pk2(x1.z * sg[6] * bflo(g.w), x1.w * sg[7] * bfhi(g.w));
      *(v4u*)(CATb + grow * 1024 + ch * 8) = w; }
  }
  __syncthreads();
#undef SLOAD
#undef SWRITE
#undef SWAIT
#undef RESC
}
#undef KSWZ
#undef SBAR
}

namespace ssm {
using f32x16 = __attribute__((ext_vector_type(16))) float;
constexpr int SROW = 528;
constexpr size_t WA_ELEMS = 16 * 8 * 64 * 8, WC_ELEMS = 32 * 8 * 64 * 8, W_ELEMS = WA_ELEMS + WC_ELEMS;
constexpr int SIDE_F32 = 2 * 64 * 2 * 2;

struct Cplx { float re, im; };
__device__ __forceinline__ Cplx cmul(Cplx a, Cplx b) { return {a.re * b.re - a.im * b.im, a.re * b.im + a.im * b.re}; }

constexpr int NPART = 4;
__device__ __forceinline__ void precompute(int g, int part, const float* A_re, const float* A_im, const float* log_dt, const float* B_re, const float* B_im, const float* C_re, const float* C_im,
                                           const float* Dskip, bf16_t* W, float* side, LAS unsigned char* lds, int tid) {
    LAS float* apow = (LAS float*)lds;
    LAS float* bbar = (LAS float*)(lds + 17408);
    LAS float* Cc   = (LAS float*)(lds + 33792);
    LAS float* Kt   = (LAS float*)(lds + 50176);
    LAS float* Dl   = (LAS float*)(lds + 82944);
    LAS float* fz   = (LAS float*)(lds + 83008);
    if (tid < 128) { const int d = tid >> 6, p = tid & 63, dg = d * 32 + g;
        const float dt = expf(log_dt[dg]), Ar = A_re[dg * 64 + p], Ai = A_im[dg * 64 + p];
        const float mag = expf(Ar * dt); const Cplx ab = {mag * cosf(Ai * dt), mag * sinf(Ai * dt)};
        const float nr = ab.re - 1.f, ni = ab.im, den = Ar * Ar + Ai * Ai;
        fz[(d * 64 + p) * 2] = (nr * Ar + ni * Ai) / den; fz[(d * 64 + p) * 2 + 1] = (ni * Ar - nr * Ai) / den;
        Cplx pw = {1.f, 0.f};
        for (int m = 0; m <= 16; ++m) { apow[((d * 17 + m) * 64 + p) * 2] = pw.re; apow[((d * 17 + m) * 64 + p) * 2 + 1] = pw.im; if (m < 16) pw = cmul(pw, ab); }
        if (part == 0) { side[(d * 64 + p) * 2] = pw.re; side[(d * 64 + p) * 2 + 1] = pw.im;
            Cplx q = pw; for (int s = 0; s < 4; ++s) q = cmul(q, q);
            side[256 + (d * 64 + p) * 2] = q.re; side[256 + (d * 64 + p) * 2 + 1] = q.im; }
    }
    if (tid < 16) Dl[tid] = Dskip[g * 16 + tid];
    float br[4], bi[4];
#pragma unroll
    for (int j = 0; j < 4; ++j) { const int idx = tid + 512 * j, d = idx >> 10, rem = idx & 1023; const size_t o = (size_t)(d * 32 + g) * 1024 + rem;
        br[j] = B_re[o]; bi[j] = B_im[o]; Cc[idx * 2] = C_re[o]; Cc[idx * 2 + 1] = C_im[o]; }
    __syncthreads();
#pragma unroll
    for (int j = 0; j < 4; ++j) { const int idx = tid + 512 * j, dp = idx >> 4; const Cplx f = {fz[dp * 2], fz[dp * 2 + 1]}; const Cplx bb = cmul(f, (Cplx){br[j], bi[j]});
        bbar[idx * 2] = bb.re; bbar[idx * 2 + 1] = bb.im; }
    __syncthreads();
    { const int d = tid >> 8, m = (tid >> 4) & 15, hp = tid & 15; float sacc[16];
#pragma unroll
      for (int h = 0; h < 16; ++h) sacc[h] = 0.f;
#pragma unroll 2
      for (int p = 0; p < 64; ++p) { const Cplx c = {Cc[((d * 16 + hp) * 64 + p) * 2], Cc[((d * 16 + hp) * 64 + p) * 2 + 1]};
          const Cplx a = {apow[((d * 17 + m) * 64 + p) * 2], apow[((d * 17 + m) * 64 + p) * 2 + 1]}; const Cplx ca = cmul(c, a);
          const LAS f32x4* bp = (const LAS f32x4*)(bbar + (d * 64 + p) * 32);
#pragma unroll
          for (int h2 = 0; h2 < 8; ++h2) { const f32x4 b = bp[h2]; sacc[2 * h2] += ca.re * b.x - ca.im * b.y; sacc[2 * h2 + 1] += ca.re * b.z - ca.im * b.w; } }
#pragma unroll
      for (int h = 0; h < 16; ++h) Kt[tid * 16 + h] = sacc[h]; }
    __syncthreads();
    for (int o = part * (8192 / NPART) + tid; o < (part + 1) * (8192 / NPART); o += 512) { const int i = o >> 9, nt = (o >> 6) & 7, l = o & 63, d = nt >> 2, q = nt & 3, p = (l & 31) + 32 * (q >> 1), comp = q & 1, m = d == 0 ? 15 - i : i;
        const Cplx a = {apow[((d * 17 + m) * 64 + p) * 2], apow[((d * 17 + m) * 64 + p) * 2 + 1]};
        unsigned w[4];
#pragma unroll
        for (int e2 = 0; e2 < 4; ++e2) { float v[2];
#pragma unroll
            for (int t = 0; t < 2; ++t) { const int h = 8 * (l >> 5) + 2 * e2 + t; const Cplx b = {bbar[((d * 64 + p) * 16 + h) * 2], bbar[((d * 64 + p) * 16 + h) * 2 + 1]}; const Cplx z = cmul(a, b); v[t] = comp ? z.im : z.re; }
            w[e2] = pk2(v[0], v[1]); }
        *(GAS v4u*)(W + (size_t)o * 8) = (v4u){w[0], w[1], w[2], w[3]}; }
    for (int o = part * (16384 / NPART) + tid; o < (part + 1) * (16384 / NPART); o += 512) { const int ks = o >> 9, nt = (o >> 6) & 7, l = o & 63, cq = 32 * nt + (l & 31), j = cq >> 4, hp = cq & 15;
        unsigned w[4];
#pragma unroll
        for (int e2 = 0; e2 < 4; ++e2) { float v[2];
#pragma unroll
            for (int t = 0; t < 2; ++t) { const int e = 2 * e2 + t; float val;
                if (ks < 16) { const int i = ks, h = 8 * (l >> 5) + e; val = 0.f;
                    if (i <= j) val += Kt[((0 * 16 + (j - i)) * 16 + hp) * 16 + h];
                    if (i >= j) val += Kt[((1 * 16 + (i - j)) * 16 + hp) * 16 + h];
#ifndef SSM_PROBE
                    if (i == j && h == hp) val += Dl[h];
#endif
                    }
                else { const int kk = ks - 16, d = kk >> 3, kidx = 16 * (kk & 7) + 8 * (l >> 5) + e, p = kidx >> 1, comp = kidx & 1, m = d == 0 ? j + 1 : 16 - j;
                    const Cplx c = {Cc[((d * 16 + hp) * 64 + p) * 2], Cc[((d * 16 + hp) * 64 + p) * 2 + 1]};
                    const Cplx a = {apow[((d * 17 + m) * 64 + p) * 2], apow[((d * 17 + m) * 64 + p) * 2 + 1]};
                    const Cplx z = cmul(c, a); val = comp ? -z.im : z.re; }
                v[t] = val; }
            w[e2] = pk2(v[0], v[1]); }
        *(GAS v4u*)(W + WA_ELEMS + (size_t)o * 8) = (v4u){w[0], w[1], w[2], w[3]}; }
    __syncthreads();
}

template <int DIR, int KIND>
__device__ __forceinline__ void scan(const f32x16 (&x)[2][2], Cplx aT, Cplx aT16, Cplx h0, int hi, LAS unsigned char* SL, int col  , int mt0, Cplx (&fin)[2]) {
    Cplx cin[2];
    if (KIND == 1) {
        Cplx e[2];
#pragma unroll
        for (int m = 0; m < 2; ++m) { Cplx a = {0.f, 0.f};
#pragma unroll
            for (int s = 0; s < 16; ++s) { const int r = DIR ? 15 - s : s; const Cplx t = cmul(a, aT); a.re = t.re + x[m][0][r]; a.im = t.im + x[m][1][r]; }
            e[m] = a; }
        Cplx eo[2];
#pragma unroll
        for (int m = 0; m < 2; ++m) { eo[m].re = __shfl_xor(e[m].re, 32); eo[m].im = __shfl_xor(e[m].im, 32); }
        Cplx eA[2], eB[2];
#pragma unroll
        for (int m = 0; m < 2; ++m) { eA[m] = hi ? eo[m] : e[m]; eB[m] = hi ? e[m] : eo[m]; }
        Cplx c00, c01, c10, c11;
        if (DIR == 0) { c00 = h0; Cplx t = cmul(aT16, c00); c01 = {t.re + eA[0].re, t.im + eA[0].im}; t = cmul(aT16, c01); c10 = {t.re + eB[0].re, t.im + eB[0].im}; t = cmul(aT16, c10); c11 = {t.re + eA[1].re, t.im + eA[1].im}; }
        else { c11 = h0; Cplx t = cmul(aT16, c11); c10 = {t.re + eB[1].re, t.im + eB[1].im}; t = cmul(aT16, c10); c01 = {t.re + eA[1].re, t.im + eA[1].im}; t = cmul(aT16, c01); c00 = {t.re + eB[0].re, t.im + eB[0].im}; }
        cin[0] = hi ? c01 : c00; cin[1] = hi ? c11 : c10;
    } else { cin[0] = {0.f, 0.f}; cin[1] = {0.f, 0.f}; }
#pragma unroll
    for (int m = 0; m < 2; ++m) { Cplx s = cin[m];
#pragma unroll
        for (int q = 0; q < 16; ++q) { const int r = DIR ? 15 - q : q; const int rho = (r & 3) + 8 * (r >> 2) + 4 * hi;
            *(LAS unsigned*)(SL + ((mt0 + m) * 32 + rho) * 512 + ((((col >> 3) ^ (rho & 15)) << 4) | ((col & 7) * 2))) = pk2(s.re, s.im);
            const Cplx t = cmul(s, aT); s.re = t.re + x[m][0][r]; s.im = t.im + x[m][1][r]; }
        fin[m] = s; }
}

__device__ __forceinline__ int item_tok(int kind, int b0, int mt, int rho) { const int hr = (rho >> 2) & 1, rr = (rho & 3) + 4 * (rho >> 3);
    return kind ? NTOK_I + (b0 + (mt >> 1)) * 1024 + 16 * (32 * (mt & 1) + 16 * hr + rr) : (b0 + 2 * mt + hr) * 256 + 16 * rr; }
#define SSM_MMA4(ACC, A0, A1, B0, B1) do { \
        ACC[0][0] = __builtin_amdgcn_mfma_f32_32x32x16_bf16(A0, B0, ACC[0][0], 0, 0, 0); ACC[0][1] = __builtin_amdgcn_mfma_f32_32x32x16_bf16(A0, B1, ACC[0][1], 0, 0, 0); \
        ACC[1][0] = __builtin_amdgcn_mfma_f32_32x32x16_bf16(A1, B0, ACC[1][0], 0, 0, 0); ACC[1][1] = __builtin_amdgcn_mfma_f32_32x32x16_bf16(A1, B1, ACC[1][1], 0, 0, 0); } while (0)
__device__ __forceinline__ void item(int g, int kind, int b0, const bf16_t* U, const bf16_t* Wg, const float* side, const float* state_ssm, bf16_t* YS, float* out, LAS unsigned char* lds) {
    int tid_ = threadIdx.x; asm volatile("" : "+v"(tid_));
    const int tid = tid_, wid = __builtin_amdgcn_readfirstlane(tid >> 6), lane = tid & 63, r32 = lane & 31, hi = lane >> 5, mp = wid & 1, nq = wid >> 1;
    LAS unsigned char* UL = lds; LAS unsigned char* SL = lds + 65536;
    const bf16x8* WA = (const bf16x8*)Wg + 2 * nq * 64 + lane; const bf16x8* WC = (const bf16x8*)(Wg + WA_ELEMS) + 2 * nq * 64 + lane;
    {   v4u pc[8];
#pragma unroll
        for (int j = 0; j < 8; ++j) { const int id = tid + 512 * j, row = id >> 5, ch = id & 31;
            pc[j] = *(const GAS v4u*)(U + (size_t)(item_tok(kind, b0, row >> 5, row & 31) + (ch >> 1)) * 512 + g * 16 + (ch & 1) * 8); }
#pragma unroll
        for (int j = 0; j < 8; ++j) { const int id = tid + 512 * j, row = id >> 5, ch = id & 31; *(LAS v4u*)(UL + row * 512 + ((ch ^ (row & 15)) << 4)) = pc[j]; }
    }
    bf16x8 bq[4][2];
#pragma unroll
    for (int s4 = 0; s4 < 4; ++s4) { bq[s4][0] = WA[s4 * 512]; bq[s4][1] = WA[s4 * 512 + 64]; }
    __syncthreads();
    const LAS unsigned char* ua0 = UL + ((2 * mp) * 32 + r32) * 512; const LAS unsigned char* ua1 = ua0 + 32 * 512; const int sw = r32 & 15;
    f32x16 x[2][2];
#pragma unroll
    for (int m = 0; m < 2; ++m)
#pragma unroll
        for (int t = 0; t < 2; ++t) x[m][t] = f32x16{};
#define SSM_STEP(ACC, P0, P1, II, PREF) do { const bf16x8 a0 = *(const LAS bf16x8*)((P0) + (((2 * (II) + hi) ^ sw) << 4)), a1 = *(const LAS bf16x8*)((P1) + (((2 * (II) + hi) ^ sw) << 4)); \
        SSM_MMA4(ACC, a0, a1, bq[i & 3][0], bq[i & 3][1]); __builtin_amdgcn_sched_barrier(0); PREF; __builtin_amdgcn_sched_barrier(0); } while (0)
#pragma unroll 4
    for (int i = 0; i < 12; ++i) SSM_STEP(x, ua0, ua1, i, (bq[i & 3][0] = WA[(i + 4) * 512], bq[i & 3][1] = WA[(i + 4) * 512 + 64]));
#pragma unroll
    for (int i = 12; i < 16; ++i) SSM_STEP(x, ua0, ua1, i, (bq[i & 3][0] = WC[(i - 12) * 512], bq[i & 3][1] = WC[(i - 12) * 512 + 64]));
    { const int d = nq >> 1, p = r32 + 32 * (nq & 1);
      const Cplx aT = {side[(d * 64 + p) * 2], side[(d * 64 + p) * 2 + 1]}, aT16 = {side[256 + (d * 64 + p) * 2], side[256 + (d * 64 + p) * 2 + 1]};
      Cplx h0 = {0.f, 0.f};
      if (kind) { const size_t sb = ((size_t)((b0 + mp) * 2 + d) * 2) * 2048 + g * 64 + p; h0.re = state_ssm[sb]; h0.im = state_ssm[sb + 2048]; }
      Cplx fin[2];
      if (kind) { if (d == 0) scan<0, 1>(x, aT, aT16, h0, hi, SL, d * 128 + 2 * p, 2 * mp, fin); else scan<1, 1>(x, aT, aT16, h0, hi, SL, d * 128 + 2 * p, 2 * mp, fin); }
      else { if (d == 0) scan<0, 0>(x, aT, aT16, h0, hi, SL, d * 128 + 2 * p, 2 * mp, fin); else scan<1, 0>(x, aT, aT16, h0, hi, SL, d * 128 + 2 * p, 2 * mp, fin);
#pragma unroll
          for (int m = 0; m < 2; ++m) { const int b = b0 + 2 * (2 * mp + m) + hi; const size_t sb = ((size_t)(b * 2 + d) * 2) * 2048 + g * 64 + p; out[O_NS + sb] = fin[m].re; out[O_NS + sb + 2048] = fin[m].im; } }
    }
    __syncthreads();
    f32x16 y[2][2];
#pragma unroll
    for (int m = 0; m < 2; ++m)
#pragma unroll
        for (int t = 0; t < 2; ++t) y[m][t] = f32x16{};
    const LAS unsigned char* sa0 = SL + ((2 * mp) * 32 + r32) * 512; const LAS unsigned char* sa1 = sa0 + 32 * 512;
#pragma unroll 4
    for (int i = 0; i < 16; ++i) SSM_STEP(y, ua0, ua1, i, (bq[i & 3][0] = WC[(i + 4) * 512], bq[i & 3][1] = WC[(i + 4) * 512 + 64]));
#pragma unroll 4
    for (int i = 16; i < 28; ++i) SSM_STEP(y, sa0, sa1, i - 16, (bq[i & 3][0] = WC[(i + 4) * 512], bq[i & 3][1] = WC[(i + 4) * 512 + 64]));
#pragma unroll
    for (int i = 28; i < 32; ++i) SSM_STEP(y, sa0, sa1, i - 16, (void)0);
#undef SSM_STEP
    __syncthreads();
#pragma unroll
    for (int m = 0; m < 2; ++m)
#pragma unroll
        for (int r = 0; r < 16; ++r) { const int rho = (r & 3) + 8 * (r >> 2) + 4 * hi, row = (2 * mp + m) * 32 + rho;
#pragma unroll
            for (int t = 0; t < 2; ++t) { const int cq = 64 * nq + 32 * t + r32, ch = cq >> 3;
#ifdef SSM_PROBE
                { const int j = cq >> 4, hp = cq & 15; ((float*)YS)[(size_t)(item_tok(kind, b0, 2 * mp + m, rho) + j) * 512 + g * 16 + hp] = y[m][t][r]; }
#endif
                *(LAS bf16_t*)(UL + row * 512 + ((ch ^ (rho & 15)) << 4) + (cq & 7) * 2) = (bf16_t)f2bf(fast_gelu_tanh(y[m][t][r])); } }
    __syncthreads();
#ifndef SSM_PROBE
#pragma unroll
    for (int j = 0; j < 8; ++j) { const int id = tid + 512 * j, row = id >> 5, ch = id & 31;
        const v4u v = *(const LAS v4u*)(UL + row * 512 + ((ch ^ (row & 15)) << 4));
        *(GAS v4u*)(YS + (size_t)(item_tok(kind, b0, row >> 5, row & 31) + (ch >> 1)) * 512 + g * 16 + (ch & 1) * 8) = v; }
#endif
    __syncthreads();
}
#undef SSM_MMA4
}

constexpr int NWAVES = 8, NTHREADS = 512;
constexpr int RING_BYTES = 131072, LDSCTL_OFF = RING_BYTES, MISC_OFF = LDSCTL_OFF + 320, LDS_BYTES = 147456;
constexpr int CW_BAR = 4096;
static_assert((CW_BAR + XCD_BAR_WORDS) * 4 <= (int)CTL_ZERO_BYTES, "barrier words inside the memset region");
constexpr int NPHASE = 7;

struct Args { const float* in[25]; float* out; unsigned char* ws; int ph_lo, ph_hi; int rep[8]; int p3mask, pad; };

struct Frame {
    LAS unsigned char* lds; int tid, lane, wave, G;
    const float *x_prompt, *x_sample, *cache_k, *cache_v, *state_ssm, *c, *c_ctx, *w_ada, *b_ada, *norm_pre, *norm_post, *w_in, *lambda_qk, *subln;
    const float *A_re, *A_im, *log_dt, *B_re, *B_im, *C_re, *C_im, *ssm_D, *w_glu, *b_glu, *w_out;
    float* out; float *PART, *MISC, *ROPE, *OUT;
    bf16_t *WIN, *WGLU, *WOUT, *XN, *Q, *KALL, *VALL, *GA, *U, *GS, *YS, *CAT, *SSMW; float* SIDE;
};

__device__ __forceinline__ void p0_adaln_part(Frame& F, int wg) {
    const int kb = wg >> 5, cc = wg & 31;
    LAS float* sc = (LAS float*)F.lds;
    LAS float* red = (LAS float*)(F.lds + 8192);
    for (int i = F.tid; i < 9 * 128; i += NTHREADS) { const int ci = i >> 7, k = 128 * kb + (i & 127); const float v = ci == 0 ? F.c_ctx[k] : F.c[(ci - 1) * DM + k]; sc[i] = siluf(v); }
    __syncthreads();
    const int c4 = F.tid % 24, rg = F.tid / 24;
    if (rg < 21) {
        f32x4 w[7];
#pragma unroll
        for (int j = 0; j < 7; ++j) { const int r = rg + 21 * j; w[j] = r < 128 ? *(const GAS f32x4*)(F.w_ada + (size_t)(128 * kb + r) * DIN + 96 * cc + 4 * c4) : (f32x4){0.f, 0.f, 0.f, 0.f}; }
#pragma unroll
        for (int ci = 0; ci < 9; ++ci) { f32x4 a = {0.f, 0.f, 0.f, 0.f};
#pragma unroll
            for (int j = 0; j < 7; ++j) { const int r = rg + 21 * j; const float sv = r < 128 ? sc[ci * 128 + r] : 0.f; a += w[j] * sv; }
            *(LAS f32x4*)(red + (rg * 9 + ci) * 96 + 4 * c4) = a; }
    }
    __syncthreads();
    for (int o = F.tid; o < 9 * 96; o += NTHREADS) { float sum = 0.f;
#pragma unroll
        for (int r = 0; r < 21; ++r) sum += red[r * 864 + o];
        const int ci = o / 96, col = o % 96; F.PART[(size_t)(kb * 9 + ci) * DIN + 96 * cc + col] = sum; }
    __syncthreads();
}
__device__ __forceinline__ void mod_to_lds(Frame& F, LAS float* MODL, int ci0, int ci1, int col0, int n) {
    for (int i = F.tid; i < 2 * n; i += NTHREADS) { const int j = i >= n, col = col0 + (j ? i - n : i), ci = j ? ci1 : ci0; float sum = F.b_ada[col];
#pragma unroll
        for (int kb = 0; kb < 8; ++kb) sum += F.PART[(size_t)(kb * 9 + ci) * DIN + col];
        MODL[i] = sum; }
    __syncthreads();
}
__device__ __forceinline__ void p0_transpose_item(const float* W, int K, int N, bf16_t* WT, LAS float* scr, int item, int lane) {
    const int nblk = N / 32, kb = item / nblk, nb = item % nblk, k0 = 64 * kb, n0 = 32 * nb;
#pragma unroll 8
    for (int i = 0; i < 32; ++i) { const int kk = 2 * i + (lane >> 5); scr[kk * 33 + (lane & 31)] = W[(size_t)(k0 + kk) * N + n0 + (lane & 31)]; }
    LDS_WAIT(); asm volatile("" ::: "memory");
    const int c = lane & 7;
#pragma unroll
    for (int j = 0; j < 4; ++j) { const int n = (lane >> 3) + 8 * j; const LAS float* s = scr + (8 * c) * 33 + n;
        v4u o; o.x = pk2(s[0 * 33], s[1 * 33]); o.y = pk2(s[2 * 33], s[3 * 33]); o.z = pk2(s[4 * 33], s[5 * 33]); o.w = pk2(s[6 * 33], s[7 * 33]);
        *(GAS v4u*)(WT + (size_t)(n0 + n) * K + k0 + 8 * c) = o; }
    LDS_WAIT(); asm volatile("" ::: "memory");
}
__device__ __forceinline__ void p0_prologue(Frame& F, int pm) {
    const int wg = blockIdx.x;
    if (pm & 1) p0_adaln_part(F, wg);
    if ((pm & 2) && wg < 32 * ssm::NPART) { const int g = wg / ssm::NPART;
        ssm::precompute(g, wg % ssm::NPART, F.A_re, F.A_im, F.log_dt, F.B_re, F.B_im, F.C_re, F.C_im, F.ssm_D, F.SSMW + (size_t)g * ssm::W_ELEMS, F.SIDE + g * ssm::SIDE_F32, F.lds, F.tid); }
    if ((pm & 8) && wg == F.G - 1) {
        for (int t = F.tid; t < 1024; t += NTHREADS) { const int pos = t >> 4, f = t & 15; const float inv = powf(10000.f, -(float)f / 16.f), ang = (float)pos * inv;
            F.ROPE[pos * 16 + f] = cosf(ang); F.ROPE[1024 + pos * 16 + f] = sinf(ang); }
        if (F.tid == 0) { float s1 = 0.f, s2 = 0.f; for (int i = 0; i < 64; ++i) { s1 += F.lambda_qk[i] * F.lambda_qk[64 + i]; s2 += F.lambda_qk[128 + i] * F.lambda_qk[192 + i]; }
            F.MISC[0] = expf(s1) - expf(s2) + LAM_INIT; }
    }
    LAS float* scr = (LAS float*)(F.lds + F.wave * 16384);
    const int NGW = F.G * NWAVES, o = ((wg + F.G - 32 * ssm::NPART) % F.G) * NWAVES + F.wave;
    constexpr int I_IN = (DM / 64) * (DIN / 32), I_GLU = (512 / 64) * (512 / 32), I_OUT = (DM / 64) * (DM / 32), NITEMS = I_IN + I_GLU + I_OUT;
    if (pm & 4) for (int it = o; it < NITEMS; it += NGW) {
        int r = it;
        if (r < I_IN) { p0_transpose_item(F.w_in, DM, DIN, F.WIN, scr, r, F.lane); continue; } r -= I_IN;
        if (r < I_GLU) { p0_transpose_item(F.w_glu, 512, 512, F.WGLU, scr, r, F.lane); continue; } r -= I_GLU;
        p0_transpose_item(F.w_out, DM, DM, F.WOUT, scr, r, F.lane);
    }
    if (pm & 8) { const int n4 = 8 * 256 * 512 / 4;
        for (int i = wg * NTHREADS + F.tid; i < 2 * n4; i += F.G * NTHREADS) { const bool isv = i >= n4; const int j = isv ? i - n4 : i;
            const f32x4 v = ((const GAS f32x4*)(isv ? F.cache_v : F.cache_k))[j];
            const int b = j / (256 * 128), rem = j % (256 * 128); v2u w; w.x = pk2(v.x, v.y); w.y = pk2(v.z, v.w);
            ((GAS v2u*)((isv ? F.VALL : F.KALL) + (size_t)(4096 + b * 1280) * 512))[rem] = w; } }
}
__device__ __forceinline__ void p1_prep_x(Frame& F) {
    constexpr int RPB = NTOK / 256;
    const int row0 = blockIdx.x * RPB, ci0 = mod_index(row0), ci1 = mod_index(row0 + RPB - 1);
    LAS float* MODL = (LAS float*)F.lds;
    mod_to_lds(F, MODL, ci0, ci1, 0, 2048);
    for (int m = row0 + F.wave; m < row0 + RPB; m += NWAVES) {
        const float* xr = m < NTOK_I ? F.x_prompt + (size_t)m * DM : F.x_sample + (size_t)(m - NTOK_I) * DM;
        const LAS float* shift = MODL + (mod_index(m) == ci0 ? 0 : 2048); const LAS float* scale = shift + DM;
        f32x4 v[4]; float ss = 0.f;
#pragma unroll
        for (int j = 0; j < 4; ++j) { v[j] = ((const GAS f32x4*)xr)[F.lane + 64 * j]; ss += (v[j].x * v[j].x + v[j].y * v[j].y) + (v[j].z * v[j].z + v[j].w * v[j].w); }
        ss = wave_sum(ss); const float r = rsqrtf(ss * (1.f / DM) + EPS);
#pragma unroll
        for (int j = 0; j < 4; ++j) { const int i4 = F.lane + 64 * j;
            const f32x4 g = ((const GAS f32x4*)F.norm_pre)[i4], sc = ((const LAS f32x4*)scale)[i4], sh = ((const LAS f32x4*)shift)[i4];
            v2u o; o.x = pk2(v[j].x * r * g.x * (1.f + sc.x) + sh.x, v[j].y * r * g.y * (1.f + sc.y) + sh.y);
            o.y = pk2(v[j].z * r * g.z * (1.f + sc.z) + sh.z, v[j].w * r * g.w * (1.f + sc.w) + sh.w);
            ((GAS v2u*)(F.XN + (size_t)m * DM))[i4] = o; }
    }
    __syncthreads();
}
struct EpiIn {
    static constexpr bool PERM = false, AFTER_DRAIN = false;
    bf16_t *Q, *KALL, *VALL, *GA, *U, *GS; float* out; const float* ROPE;
    __device__ __forceinline__ void operator()(const pg8::f32x4 (&acc)[2][2][4][2], const pg8::Unit& u, int wr, int wc, int fr, int fq) const {
        const int sec = u.pn >> 1, cbase = (u.pn & 1) * 256 + wc * 32 + 4 * fq, rbase = u.pm * 256 + wr * 64 + fr;
        const bool g2 = u.pm >= 16, rope = g2 && sec < 2;
#pragma unroll
        for (int ai = 0; ai < 2; ++ai)
#pragma unroll
            for (int m = 0; m < 4; ++m) {
                const int r = rbase + 128 * ai + 16 * m;
                f32x4 cs = {1.f, 1.f, 1.f, 1.f}, sn = {0.f, 0.f, 0.f, 0.f};
                if (rope) { const int t = (r - NTOK_I) & 1023, pos = (wc & 1) ? (t & 63) : (t >> 6);
                    cs = *(const GAS f32x4*)(ROPE + pos * 16 + 4 * fq); sn = *(const GAS f32x4*)(ROPE + 1024 + pos * 16 + 4 * fq); }
                const size_t krow = (size_t)key_row(r);
#pragma unroll
                for (int bj = 0; bj < 2; ++bj) {
                    const f32x4 a0 = acc[ai][bj][m][0], a1 = acc[ai][bj][m][1];
                    const f32x4 v0 = a0 * cs - a1 * sn, v1 = a1 * cs + a0 * sn;
                    const int cc = cbase + 128 * bj;
                    if (sec == 0) { bf16_t* p = Q + (size_t)r * 512 + cc;
                        *(GAS v2u*)p = (v2u){pk2(v0.x, v0.y), pk2(v0.z, v0.w)}; *(GAS v2u*)(p + 16) = (v2u){pk2(v1.x, v1.y), pk2(v1.z, v1.w)}; }
                    else if (sec == 1 || sec == 2) { bf16_t* p = (sec == 1 ? KALL : VALL) + krow * 512 + cc;
                        *(GAS v2u*)p = (v2u){pk2(v0.x, v0.y), pk2(v0.z, v0.w)}; *(GAS v2u*)(p + 16) = (v2u){pk2(v1.x, v1.y), pk2(v1.z, v1.w)};
                        if (!g2) { float* o = out + (sec == 1 ? O_NK : O_NV) + (size_t)r * 512 + cc; *(GAS f32x4*)o = v0; *(GAS f32x4*)(o + 16) = v1; } }
                    else if (sec == 4) { bf16_t* p = U + (size_t)r * 512 + cc;
                        *(GAS v2u*)p = (v2u){pk2(v0.x, v0.y), pk2(v0.z, v0.w)}; *(GAS v2u*)(p + 16) = (v2u){pk2(v1.x, v1.y), pk2(v1.z, v1.w)}; }
                    else { bf16_t* p = (sec == 3 ? GA : GS) + (size_t)r * 512 + cc;
                        *(GAS v2u*)p = (v2u){pk2(fast_silu(v0.x), fast_silu(v0.y)), pk2(fast_silu(v0.z), fast_silu(v0.w))};
                        *(GAS v2u*)(p + 16) = (v2u){pk2(fast_silu(v1.x), fast_silu(v1.y)), pk2(fast_silu(v1.z), fast_silu(v1.w))}; }
                }
            }
    }
};

struct EpiGlu {
    static constexpr bool PERM = true, AFTER_DRAIN = false;
    const bf16_t *YS, *GS; const float* b_glu; bf16_t* CAT;
    __device__ __forceinline__ void operator()(const pg8::f32x4 (&acc)[2][2][4][2], const pg8::Unit& u, int wr, int wc, int fr, int fq) const {
        const int cbase = u.pn * 256 + wc * 32 + 8 * fq, rbase = u.pm * 256 + wr * 64 + fr;
#pragma unroll
        for (int bj = 0; bj < 2; ++bj) { const int c = cbase + 128 * bj;
            const f32x4 b0 = *(const GAS f32x4*)(b_glu + c), b1 = *(const GAS f32x4*)(b_glu + c + 4);
#pragma unroll
            for (int ai = 0; ai < 2; ++ai)
#pragma unroll
                for (int m = 0; m < 4; ++m) { const size_t r = (size_t)(rbase + 128 * ai + 16 * m);
                    const v4u y = *(const GAS v4u*)(YS + r * 512 + c), g = *(const GAS v4u*)(GS + r * 512 + c);
                    const f32x4 a0 = acc[ai][bj][m][0] + b0, a1 = acc[ai][bj][m][1] + b1;
                    v4u o;
                    o.x = pk2(bflo(y.x) * fast_sigmoid(a0.x) * bflo(g.x), bfhi(y.x) * fast_sigmoid(a0.y) * bfhi(g.x));
                    o.y = pk2(bflo(y.y) * fast_sigmoid(a0.z) * bflo(g.y), bfhi(y.y) * fast_sigmoid(a0.w) * bfhi(g.y));
                    o.z = pk2(bflo(y.z) * fast_sigmoid(a1.x) * bflo(g.z), bfhi(y.z) * fast_sigmoid(a1.y) * bfhi(g.z));
                    o.w = pk2(bflo(y.w) * fast_sigmoid(a1.z) * bflo(g.w), bfhi(y.w) * fast_sigmoid(a1.w) * bfhi(g.w));
                    *(GAS v4u*)(CAT + r * 1024 + 512 + c) = o; } }
    }
};
struct EpiOut {
    static constexpr bool PERM = false, AFTER_DRAIN = false;
    float* OUT;
    __device__ __forceinline__ void operator()(const pg8::f32x4 (&acc)[2][2][4][2], const pg8::Unit& u, int wr, int wc, int fr, int fq) const {
        const int cbase = u.pn * 256 + wc * 32 + 4 * fq, rbase = u.pm * 256 + wr * 64 + fr;
#pragma unroll
        for (int ai = 0; ai < 2; ++ai)
#pragma unroll
            for (int m = 0; m < 4; ++m) { float* o = OUT + (size_t)(rbase + 128 * ai + 16 * m) * 1024 + cbase;
#pragma unroll
                for (int bj = 0; bj < 2; ++bj) { *(GAS f32x4*)(o + 128 * bj) = acc[ai][bj][m][0]; *(GAS f32x4*)(o + 128 * bj + 16) = acc[ai][bj][m][1]; } }
    }
};
__device__ __forceinline__ void p6_final(Frame& F) {
    constexpr int RPB = NTOK / 256;
    const int row0 = blockIdx.x * RPB, ci0 = mod_index(row0), ci1 = mod_index(row0 + RPB - 1);
    LAS float* MODL = (LAS float*)F.lds;
    mod_to_lds(F, MODL, ci0, ci1, 2048, 1024);
    for (int m = row0 + F.wave; m < row0 + RPB; m += NWAVES) {
        const float* xr = m < NTOK_I ? F.x_prompt + (size_t)m * DM : F.x_sample + (size_t)(m - NTOK_I) * DM;
        const LAS float* gate = MODL + (mod_index(m) == ci0 ? 0 : 1024); const float* orow = F.OUT + (size_t)m * DM;
        f32x4 v[4]; float ss = 0.f;
#pragma unroll
        for (int j = 0; j < 4; ++j) { v[j] = ((const GAS f32x4*)orow)[F.lane + 64 * j]; ss += (v[j].x * v[j].x + v[j].y * v[j].y) + (v[j].z * v[j].z + v[j].w * v[j].w); }
        ss = wave_sum(ss); const float r = rsqrtf(ss * (1.f / DM) + EPS);
#pragma unroll
        for (int j = 0; j < 4; ++j) { const int i4 = F.lane + 64 * j;
            const f32x4 g = ((const GAS f32x4*)F.norm_post)[i4], ga = ((const LAS f32x4*)gate)[i4], x = ((const GAS f32x4*)xr)[i4];
            ((GAS f32x4*)(F.out + (size_t)m * DM))[i4] = x + ga * (v[j] * r) * g; }
    }
    __syncthreads();
}

__global__ void __launch_bounds__(NTHREADS, 2) mega(Args args) {
    extern __shared__ __attribute__((aligned(16))) unsigned char lds_raw[];
    Frame F;
    F.lds = (LAS unsigned char*)lds_raw; F.tid = threadIdx.x; F.lane = F.tid & 63; F.wave = __builtin_amdgcn_readfirstlane(F.tid >> 6); F.G = gridDim.x;
    volatile LAS unsigned* MISCL = (volatile LAS unsigned*)(F.lds + MISC_OFF);
    unsigned char* ws = args.ws;
    F.x_prompt = args.in[0]; F.x_sample = args.in[1]; F.cache_k = args.in[2]; F.cache_v = args.in[3]; F.state_ssm = args.in[4]; F.c = args.in[5]; F.c_ctx = args.in[6];
    F.w_ada = args.in[7]; F.b_ada = args.in[8]; F.norm_pre = args.in[9]; F.norm_post = args.in[10]; F.w_in = args.in[11]; F.lambda_qk = args.in[12]; F.subln = args.in[13];
    F.A_re = args.in[14]; F.A_im = args.in[15]; F.log_dt = args.in[16]; F.B_re = args.in[17]; F.B_im = args.in[18]; F.C_re = args.in[19]; F.C_im = args.in[20];
    F.ssm_D = args.in[21]; F.w_glu = args.in[22]; F.b_glu = args.in[23]; F.w_out = args.in[24]; F.out = args.out;
    F.PART = (float*)(ws + WS_MOD); F.MISC = (float*)(ws + WS_MISC); F.ROPE = (float*)(ws + WS_ROPE); F.OUT = (float*)(ws + WS_OUT);
    F.WIN = (bf16_t*)(ws + WS_WIN); F.WGLU = (bf16_t*)(ws + WS_WGLU); F.WOUT = (bf16_t*)(ws + WS_WOUT); F.XN = (bf16_t*)(ws + WS_XN); F.Q = (bf16_t*)(ws + WS_Q);
    F.KALL = (bf16_t*)(ws + WS_K); F.VALL = (bf16_t*)(ws + WS_V); F.GA = (bf16_t*)(ws + WS_GA); F.U = (bf16_t*)(ws + WS_U); F.GS = (bf16_t*)(ws + WS_GS);
    F.YS = (bf16_t*)(ws + WS_YS); F.CAT = (bf16_t*)(ws + WS_CAT); F.SSMW = (bf16_t*)(ws + WS_SSMW); F.SIDE = (float*)(ws + WS_SIDE);
    for (int u = F.tid; u < (LDS_BYTES - LDSCTL_OFF) / 4; u += NTHREADS) ((LAS unsigned*)(F.lds + LDSCTL_OFF))[u] = 0u;
    __syncthreads();
    const int lo = args.ph_lo, hi = args.ph_hi;
    XcdBarrier bar; bar.bar = (unsigned*)(ws + WS_CTL) + CW_BAR; bar.x = 0; bar.st = nullptr;
    bar = xcd_barrier_post((unsigned*)(ws + WS_CTL) + CW_BAR, MISCL + 8);
#define IN(k) (lo <= (k) && (k) < hi)
#define SEAM(k) do { if (IN(k) && IN((k) + 1)) xcd_barrier(bar); } while (0)

#define PH0(rp) { p0_prologue(F, (rp) == 0 ? 15 : args.p3mask); }
#define PH1(rp) { p1_prep_x(F); }
#define PH2(rp) { pg8::Gemm g{F.XN, F.WIN, NTOK, DIN, DM}; pg8::StaticOrder S; S.init(NTOK, DIN, F.G, (int)blockIdx.x); \
        EpiIn E{F.Q, F.KALL, F.VALL, F.GA, F.U, F.GS, F.out, F.ROPE}; \
        pg8::gemm_phase<EpiIn, pg8::StaticOrder, true, true>(F.lds, g, S, E); }
#ifdef SSM_PROBE
#define YS_DST (bf16_t*)F.OUT
#else
#define YS_DST F.YS
#endif
#define PH3(rp) { const int pm = (rp) == 0 ? 7 : args.p3mask; \
        const float lam = __uint_as_float(__hip_atomic_load((unsigned*)F.MISC, RLX_AGENT)); \
        const int bx = blockIdx.x, vcu = (F.G % 8 == 0) ? (bx % 8) * (F.G / 8) + bx / 8 : bx;     \
        for (int u0 = vcu; u0 < 512; u0 += F.G) { \
            int u = u0; \
            if (u0 >= 256) {                                     \
                if (u0 < 256 + 192) { const int it = u0 - 256, g = it / 6, sub = it % 6; \
                    if (pm & 2) ssm::item(g, sub < 4 ? 1 : 0, sub < 4 ? 2 * sub : 8 * (sub - 4), F.U, F.SSMW + (size_t)g * ssm::W_ELEMS, F.SIDE + g * ssm::SIDE_F32, F.state_ssm, YS_DST, F.out, F.lds); \
                    continue; } \
                u = 256 + 2 * (u0 - 448); \
                if (!(pm & 4)) continue; \
            } else if (!(pm & 1)) continue; \
            for (int rep = 0; rep < (u0 >= 256 ? 2 : 1); ++rep, ++u) { \
            int tok0, kbase, seq, h; \
            if (u < 256) { const int bh = u >> 3, b = bh >> 2; h = bh & 3; tok0 = NTOK_I + b * 1024 + (u & 7) * 128; kbase = 4096 + b * 1280; seq = 1280; } \
            else { const int s = u - 256, bh = s >> 1, b = bh >> 2; h = bh & 3; tok0 = b * 256 + (s & 1) * 128; kbase = b * 256; seq = 256; } \
            att::attn_unit(F.Q + (size_t)tok0 * 512 + h * 128, F.KALL + (size_t)kbase * 512 + h * 128, F.VALL + (size_t)kbase * 512 + h * 128, seq, (char*)lds_raw, lam, \
                           F.subln, F.GA + (size_t)tok0 * 512 + h * 128, F.CAT + (size_t)tok0 * 1024 + h * 128); \
            } \
        } }
#define PH4(rp) { pg8::Gemm g{F.YS, F.WGLU, NTOK, 512, 512}; pg8::StaticOrder S; S.init(NTOK, 512, F.G, (int)blockIdx.x); \
        EpiGlu E{F.YS, F.GS, F.b_glu, F.CAT}; \
        pg8::gemm_phase<EpiGlu, pg8::StaticOrder, true, true>(F.lds, g, S, E); }
#define PH5(rp) { pg8::Gemm g{F.CAT, F.WOUT, NTOK, DM, DM}; pg8::StaticOrder S; S.init(NTOK, DM, F.G, (int)blockIdx.x); \
        EpiOut E{F.OUT}; \
        pg8::gemm_phase<EpiOut, pg8::StaticOrder, true, true>(F.lds, g, S, E); }
#define PH6(rp) { p6_final(F); }
#ifdef DUP_PHASE
#define RUN(k, BODY) do { if (IN(k)) { BODY(0) if (DUP_PHASE == (k)) { xcd_barrier(bar); BODY(1) } } } while (0)
#else
#define RUN(k, BODY) do { if (IN(k)) { BODY(0) } } while (0)
#endif
    RUN(0, PH0); SEAM(0);
    RUN(1, PH1); SEAM(1);
    RUN(2, PH2); SEAM(2);
    RUN(3, PH3); SEAM(3);
    RUN(4, PH4); SEAM(4);
    RUN(5, PH5); SEAM(5);
    RUN(6, PH6);
#undef RUN
#undef IN
#undef SEAM
}
template <class Epi> __global__ void __launch_bounds__(256) k_gemm_naive(const bf16_t* A, const bf16_t* Bt, int M, int N, int K, Epi E) {
    __shared__ float As[16][65], Bs[16][65];
    const int tx = threadIdx.x & 15, ty = threadIdx.x >> 4, m0 = blockIdx.y * 64, n0 = blockIdx.x * 64;
    float acc[4][4];
#pragma unroll
    for (int i = 0; i < 4; ++i)
#pragma unroll
        for (int j = 0; j < 4; ++j) acc[i][j] = 0.f;
    for (int k0 = 0; k0 < K; k0 += 16) {
#pragma unroll
        for (int i = 0; i < 4; ++i) { const int e = threadIdx.x + 256 * i, r = e >> 4, kk = e & 15;
            As[kk][r] = bf2f(A[(size_t)(m0 + r) * K + k0 + kk]); Bs[kk][r] = bf2f(Bt[(size_t)(n0 + r) * K + k0 + kk]); }
        __syncthreads();
#pragma unroll
        for (int kk = 0; kk < 16; ++kk) { float a[4], b[4];
#pragma unroll
            for (int i = 0; i < 4; ++i) { a[i] = As[kk][ty + 16 * i]; b[i] = Bs[kk][tx + 16 * i]; }
#pragma unroll
            for (int i = 0; i < 4; ++i)
#pragma unroll
                for (int j = 0; j < 4; ++j) acc[i][j] += a[i] * b[j]; }
        __syncthreads();
    }
#pragma unroll
    for (int i = 0; i < 4; ++i) E(m0 + ty + 16 * i, n0, tx, acc[i]);
}
struct EpiInNaive {
    bf16_t *Q, *KALL, *VALL, *GA, *U, *GS; float* out; const float* ROPE;
    __device__ void operator()(int m, int n0, int tx, const float (&v)[4]) const {
        const int sec = n0 >> 9; float w[4] = {v[0], v[1], v[2], v[3]};
        if (sec < 2 && m >= NTOK_I) {
            const int t = (m - NTOK_I) & 1023, prow = t >> 6, pcol = t & 63;
            { const float c = ROPE[prow * 16 + tx], s = ROPE[1024 + prow * 16 + tx]; w[0] = v[0] * c - v[1] * s; w[1] = v[1] * c + v[0] * s; }
            { const float c = ROPE[pcol * 16 + tx], s = ROPE[1024 + pcol * 16 + tx]; w[2] = v[2] * c - v[3] * s; w[3] = v[3] * c + v[2] * s; }
        }
#pragma unroll
        for (int j = 0; j < 4; ++j) { const int cc = (n0 & 511) + tx + 16 * j; const float x = w[j];
            if (sec == 0) Q[(size_t)m * 512 + cc] = f2bf(x);
            else if (sec == 1) { KALL[(size_t)key_row(m) * 512 + cc] = f2bf(x); if (m < NTOK_I) out[O_NK + (size_t)m * 512 + cc] = x; }
            else if (sec == 2) { VALL[(size_t)key_row(m) * 512 + cc] = f2bf(x); if (m < NTOK_I) out[O_NV + (size_t)m * 512 + cc] = x; }
            else if (sec == 3) GA[(size_t)m * 512 + cc] = f2bf(siluf(x));
            else if (sec == 4) U[(size_t)m * 512 + cc] = f2bf(x);
            else GS[(size_t)m * 512 + cc] = f2bf(siluf(x)); }
    }
};
struct EpiGluNaive {
    const bf16_t *YS, *GS; const float* b_glu; bf16_t* CAT;
    __device__ void operator()(int m, int n0, int tx, const float (&v)[4]) const {
#pragma unroll
        for (int j = 0; j < 4; ++j) { const int n = n0 + tx + 16 * j; const float ys = bf2f(YS[(size_t)m * 512 + n]), gs = bf2f(GS[(size_t)m * 512 + n]);
            CAT[(size_t)m * 1024 + 512 + n] = f2bf(ys * sigmoidf(v[j] + b_glu[n]) * gs); }
    }
};
struct EpiOutNaive {
    float* OUT;
    __device__ void operator()(int m, int n0, int tx, const float (&v)[4]) const {
#pragma unroll
        for (int j = 0; j < 4; ++j) OUT[(size_t)m * 1024 + n0 + tx + 16 * j] = v[j];
    }
};

__global__ void __launch_bounds__(256) k_attn_naive(const bf16_t* Q, const bf16_t* KALL, const bf16_t* VALL, const bf16_t* GA, const float* subln, const float* MISC, bf16_t* CAT) {
    __shared__ float P[4][2][1280]; __shared__ float qs[4][128];
    const int h = threadIdx.x >> 6, lane = threadIdx.x & 63, m = blockIdx.x;
    const int kbase = m < NTOK_I ? (m >> 8) * 256 : 4096 + ((m - NTOK_I) >> 10) * 1280, nk = m < NTOK_I ? 256 : 1280;
    const float lam = MISC[0];
    qs[h][lane] = bf2f(Q[(size_t)m * 512 + h * 128 + lane]); qs[h][64 + lane] = bf2f(Q[(size_t)m * 512 + h * 128 + 64 + lane]);
    __syncthreads();
    float mx0 = -1e30f, mx1 = -1e30f;
    for (int kk = lane; kk < nk; kk += 64) { const bf16_t* kr = KALL + (size_t)(kbase + kk) * 512 + h * 128; float s0 = 0.f, s1 = 0.f;
        for (int d = 0; d < 64; ++d) { s0 += qs[h][d] * bf2f(kr[d]); s1 += qs[h][64 + d] * bf2f(kr[64 + d]); }
        s0 *= 0.125f; s1 *= 0.125f; P[h][0][kk] = s0; P[h][1][kk] = s1; mx0 = fmaxf(mx0, s0); mx1 = fmaxf(mx1, s1); }
    mx0 = wave_max(mx0); mx1 = wave_max(mx1);
    float l0 = 0.f, l1 = 0.f;
    for (int kk = lane; kk < nk; kk += 64) { const float p0 = expf(P[h][0][kk] - mx0), p1 = expf(P[h][1][kk] - mx1); P[h][0][kk] = p0; P[h][1][kk] = p1; l0 += p0; l1 += p1; }
    l0 = wave_sum(l0); l1 = wave_sum(l1);
    const float i0 = 1.f / l0, i1 = lam / l1;
    for (int kk = lane; kk < nk; kk += 64) P[h][0][kk] = P[h][0][kk] * i0 - P[h][1][kk] * i1;
    __syncthreads();
    float o0 = 0.f, o1 = 0.f;
    for (int kk = 0; kk < nk; ++kk) { const float w = P[h][0][kk]; const bf16_t* vr = VALL + (size_t)(kbase + kk) * 512 + h * 128; o0 += w * bf2f(vr[lane]); o1 += w * bf2f(vr[64 + lane]); }
    const float ss = wave_sum(o0 * o0 + o1 * o1), r = rsqrtf(ss * (1.f / 128.f) + EPS) * (1.f - LAM_INIT);
    const size_t gi = (size_t)m * 512 + h * 128;
    CAT[(size_t)m * 1024 + h * 128 + lane] = f2bf(o0 * r * subln[lane] * bf2f(GA[gi + lane]));
    CAT[(size_t)m * 1024 + h * 128 + 64 + lane] = f2bf(o1 * r * subln[64 + lane] * bf2f(GA[gi + 64 + lane]));
}

__global__ void __launch_bounds__(64) k_ssm_naive(const bf16_t* U, const float* A_re, const float* A_im, const float* log_dt, const float* B_re, const float* B_im,
                                                  const float* C_re, const float* C_im, const float* state_ssm, float* YF, float* YB, float* out) {
    const int ub = blockIdx.x >> 6, g = (blockIdx.x >> 1) & 31, d = blockIdx.x & 1, p = threadIdx.x;
    const int L = ub < 16 ? 256 : 1024; const size_t tok0 = ub < 16 ? (size_t)ub * 256 : 4096 + (size_t)(ub - 16) * 1024;
    const int dg = d * 32 + g;
    const float dt = expf(log_dt[dg]), Ar = A_re[dg * 64 + p], Ai = A_im[dg * 64 + p];
    const float mag = expf(Ar * dt), abr = mag * cosf(Ai * dt), abi = mag * sinf(Ai * dt);
    const float nr = abr - 1.f, ni = abi, den = Ar * Ar + Ai * Ai, fr = (nr * Ar + ni * Ai) / den, fi = (ni * Ar - nr * Ai) / den;
    float bbr[16], bbi[16], cr[16], ci[16];
#pragma unroll
    for (int h = 0; h < 16; ++h) { const float Br = B_re[(size_t)(dg * 64 + p) * 16 + h], Bi = B_im[(size_t)(dg * 64 + p) * 16 + h];
        bbr[h] = fr * Br - fi * Bi; bbi[h] = fr * Bi + fi * Br; cr[h] = C_re[(size_t)(dg * 16 + h) * 64 + p]; ci[h] = C_im[(size_t)(dg * 16 + h) * 64 + p]; }
    float hr = 0.f, hi = 0.f;
    if (ub >= 16) { const size_t sb = ((size_t)((ub - 16) * 2 + d) * 2) * 2048 + g * 64 + p; hr = state_ssm[sb]; hi = state_ssm[sb + 2048]; }
    float* Y = d == 0 ? YF : YB;
    for (int s = 0; s < L; ++s) { const int t = d == 0 ? s : L - 1 - s;
        const float uval = p < 16 ? bf2f(U[(tok0 + t) * 512 + g * 16 + p]) : 0.f;
        float bur = 0.f, bui = 0.f;
#pragma unroll
        for (int h = 0; h < 16; ++h) { const float uh = __shfl(uval, h); bur += bbr[h] * uh; bui += bbi[h] * uh; }
        const float nhr = abr * hr - abi * hi + bur, nhi = abr * hi + abi * hr + bui; hr = nhr; hi = nhi;
        float yout = 0.f;
#pragma unroll
        for (int hc = 0; hc < 16; ++hc) { const float v = wave_sum(cr[hc] * hr - ci[hc] * hi); if (p == hc) yout = v; }
        if (p < 16) Y[(tok0 + t) * 512 + g * 16 + p] = yout;
    }
    if (ub < 16) { const size_t sb = ((size_t)(ub * 2 + d) * 2) * 2048 + g * 64 + p; out[O_NS + sb] = hr; out[O_NS + sb + 2048] = hi; }
}
__global__ void __launch_bounds__(256) k_ys(const float* YF, const float* YB, const bf16_t* U, const float* Dskip, bf16_t* YS) {
    const size_t n = (size_t)NTOK * 512;
    for (size_t i = blockIdx.x * 256 + threadIdx.x; i < n; i += (size_t)gridDim.x * 256) YS[i] = f2bf(gelu_tanh(YF[i] + YB[i] + Dskip[i & 511] * bf2f(U[i])));
}
__global__ void __launch_bounds__(256) k_final(const float* xp, const float* xs, const float* OUT, const float* norm_post, const float* MOD, float* out) {
    const int gw = (blockIdx.x * 256 + threadIdx.x) >> 6, lane = threadIdx.x & 63, nw = (gridDim.x * 256) >> 6;
    for (int m = gw; m < NTOK; m += nw) {
        const float* xr = m < NTOK_I ? xp + (size_t)m * DM : xs + (size_t)(m - NTOK_I) * DM;
        const float* gate = MOD + mod_index(m) * DIN + 2 * DM; const float* orow = OUT + (size_t)m * DM;
        float4 v[4]; float ss = 0.f;
#pragma unroll
        for (int j = 0; j < 4; ++j) { v[j] = ((const float4*)orow)[lane + 64 * j]; ss += v[j].x * v[j].x + v[j].y * v[j].y + v[j].z * v[j].z + v[j].w * v[j].w; }
        ss = wave_sum(ss); const float r = rsqrtf(ss * (1.f / DM) + EPS);
#pragma unroll
        for (int j = 0; j < 4; ++j) { const int i4 = lane + 64 * j; const float4 g = ((const float4*)norm_post)[i4], ga = ((const float4*)gate)[i4], x = ((const float4*)xr)[i4];
            float4 o; o.x = x.x + ga.x * v[j].x * r * g.x; o.y = x.y + ga.y * v[j].y * r * g.y; o.z = x.z + ga.z * v[j].z * r * g.z; o.w = x.w + ga.w * v[j].w * r * g.w;
            ((float4*)(out + (size_t)m * DM))[i4] = o; }
    }
}


#ifdef SSM_PROBE
__global__ void __launch_bounds__(256) k_probe_cmp(const float* YO, const float* YF, const float* YB, float* acc) {
    float num = 0.f, den = 0.f; const size_t n = (size_t)NTOK * 512;
    for (size_t i = blockIdx.x * 256 + threadIdx.x; i < n; i += (size_t)gridDim.x * 256) { const float r = YF[i] + YB[i], d = YO[i] - r; num += d * d; den += r * r; }
    num = wave_sum(num); den = wave_sum(den);
    if ((threadIdx.x & 63) == 0) { atomicAdd(acc, num); atomicAdd(acc + 1, den); }
}
__global__ void __launch_bounds__(256) k_probe_poke(float* out, const float* acc) {
    const float f = 1.f + sqrtf(acc[0] / acc[1]);
    for (size_t i = blockIdx.x * 256 + threadIdx.x; i < 4194304; i += (size_t)gridDim.x * 256) out[i] *= f;
}
#endif
static void launch_mega(const Args& a0, int lo, int hi, int grid, hipStream_t stream) {
    Args a = a0; a.ph_lo = lo; a.ph_hi = hi;
    void* params[] = {&a};
    hipError_t e = hipLaunchCooperativeKernel((const void*)mega, dim3(grid), dim3(NTHREADS), params, LDS_BYTES, stream);
    if (e != hipSuccess) fprintf(stderr, "kernel_launch: cooperative launch [%d,%d) failed: %s (grid %d)\n", lo, hi, hipGetErrorString(e), grid);
}
extern "C" void kernel_launch(void* const* d_in, const int* in_sizes, int n_in, void* d_out, int out_size, void* d_ws, size_t ws_size, hipStream_t stream) {
    static int grid = 0;
    if (grid == 0) {
        if (n_in != 25 || ws_size < WS_END) { fprintf(stderr, "kernel_launch: unexpected n_in %d / ws %zu\n", n_in, ws_size); grid = -1; return; }
        int dev = 0, cus = 0, per_cu = 0;
        hipGetDevice(&dev); hipDeviceGetAttribute(&cus, hipDeviceAttributeMultiprocessorCount, dev);
        if (hipFuncSetAttribute((const void*)mega, hipFuncAttributeMaxDynamicSharedMemorySize, LDS_BYTES) != hipSuccess) { fprintf(stderr, "kernel_launch: hipFuncSetAttribute failed\n"); grid = -1; return; }
        hipOccupancyMaxActiveBlocksPerMultiprocessor(&per_cu, (const void*)mega, NTHREADS, LDS_BYTES);
        (void)hipGetLastError();
        if (per_cu < 1) fprintf(stderr, "kernel_launch: occupancy query reports %d blocks per CU\n", per_cu);
        grid = cus;
        if (grid != 256) { fprintf(stderr, "kernel_launch: built for a 256-CU device (work decomposition assumes a grid of 256), found %d CUs\n", cus); grid = -1; return; }
    }
    if (grid < 0) return;
    const float* x_prompt = (const float*)d_in[0]; const float* x_sample = (const float*)d_in[1];
    const float* state_ssm = (const float*)d_in[4];
    const float* norm_post = (const float*)d_in[10];
    const float* subln = (const float*)d_in[13]; const float* A_re = (const float*)d_in[14]; const float* A_im = (const float*)d_in[15];
    const float* log_dt = (const float*)d_in[16]; const float* B_re = (const float*)d_in[17]; const float* B_im = (const float*)d_in[18]; const float* C_re = (const float*)d_in[19];
    const float* C_im = (const float*)d_in[20]; const float* ssm_D = (const float*)d_in[21]; const float* b_glu = (const float*)d_in[23];
    float* out = (float*)d_out; char* ws = (char*)d_ws;
    float* MOD = (float*)(ws + WS_MOD); float* MISC = (float*)(ws + WS_MISC);
    bf16_t* WGLU = (bf16_t*)(ws + WS_WGLU); bf16_t* WOUT = (bf16_t*)(ws + WS_WOUT);
    bf16_t* Q = (bf16_t*)(ws + WS_Q); bf16_t* KALL = (bf16_t*)(ws + WS_K); bf16_t* VALL = (bf16_t*)(ws + WS_V);
    bf16_t* GA = (bf16_t*)(ws + WS_GA); bf16_t* U = (bf16_t*)(ws + WS_U); bf16_t* GS = (bf16_t*)(ws + WS_GS); bf16_t* YS = (bf16_t*)(ws + WS_YS);
    bf16_t* CAT = (bf16_t*)(ws + WS_CAT); float* OUT = (float*)(ws + WS_OUT); float* YF = (float*)(ws + WS_YF); float* YB = (float*)(ws + WS_YB);

    hipMemsetAsync(ws + WS_CTL, 0, CTL_ZERO_BYTES, stream);
    Args a{};
    for (int i = 0; i < 25; ++i) a.in[i] = (const float*)d_in[i];
    a.out = out; a.ws = (unsigned char*)d_ws;
    for (int k = 0; k < 8; ++k) a.rep[k] = 1;
    a.p3mask = 7;
#ifdef DUP_PHASE
#ifdef DUP_P3MASK
    a.p3mask = DUP_P3MASK;
#endif
#endif
#ifndef SSM_PROBE
    launch_mega(a, 0, 7, grid, stream);
#else
    launch_mega(a, 0, 2, grid, stream);
    launch_mega(a, 2, 3, grid, stream);
    launch_mega(a, 3, 4, grid, stream);
#ifdef SSM_PROBE
    k_ssm_naive<<<24 * 64, 64, 0, stream>>>(U, A_re, A_im, log_dt, B_re, B_im, C_re, C_im, state_ssm, YF, YB, out);
    k_ys<<<2048, 256, 0, stream>>>(YF, YB, U, ssm_D, YS);
    k_probe_cmp<<<1024, 256, 0, stream>>>(OUT, YF, YB, (float*)(ws + WS_CTL) + 60000);
#endif
    launch_mega(a, 4, 5, grid, stream);
    launch_mega(a, 5, 6, grid, stream);
    launch_mega(a, 6, 7, grid, stream);
    k_probe_poke<<<4096, 256, 0, stream>>>(out, (float*)(ws + WS_CTL) + 60000);
#endif
#ifdef SSM_PROBE_NEVER
    k_probe_poke<<<4096, 256, 0, stream>>>(out, (float*)(ws + WS_CTL) + 60000);
#endif
}
```

```cpp
#include <hip/hip_runtime.h>
#include <cstdint>
#include <cstdio>
#include <cmath>

typedef unsigned short bf16_t;
#define GAS __attribute__((address_space(1)))
#define LAS __attribute__((address_space(3)))
typedef unsigned v4u __attribute__((ext_vector_type(4)));
typedef unsigned v2u __attribute__((ext_vector_type(2)));
typedef float f32x4 __attribute__((ext_vector_type(4)));
typedef short bf16x8 __attribute__((ext_vector_type(8)));
typedef GAS unsigned gu32;
typedef GAS unsigned long long gu64;
#define RLX_AGENT __ATOMIC_RELAXED, __HIP_MEMORY_SCOPE_AGENT
#define LDS_WAIT() asm volatile("s_waitcnt lgkmcnt(0)" ::: "memory")
#define VM_WAIT() asm volatile("s_waitcnt vmcnt(0)" ::: "memory")
__device__ __forceinline__ unsigned f2bf(float f) { unsigned u = __builtin_bit_cast(unsigned, f); return (u + 0x7fffu + ((u >> 16) & 1u)) >> 16; }
__device__ __forceinline__ unsigned pk2(float lo, float hi) { return f2bf(lo) | (f2bf(hi) << 16); }
__device__ __forceinline__ float bf2f(bf16_t h) { return __uint_as_float(((unsigned)h) << 16); }
__device__ __forceinline__ float bflo(unsigned w) { return __uint_as_float(w << 16); }
__device__ __forceinline__ float bfhi(unsigned w) { return __uint_as_float(w & 0xffff0000u); }
__device__ __forceinline__ float wave_sum(float v) {
#pragma unroll
    for (int o = 1; o < 64; o <<= 1) v += __shfl_xor(v, o);
    return v;
}
__device__ __forceinline__ float wave_max(float v) {
#pragma unroll
    for (int o = 1; o < 64; o <<= 1) v = fmaxf(v, __shfl_xor(v, o));
    return v;
}
__device__ __forceinline__ float siluf(float x) { return x / (1.f + expf(-x)); }
__device__ __forceinline__ float sigmoidf(float x) { return 1.f / (1.f + expf(-x)); }
__device__ __forceinline__ float fast_sigmoid(float x) { return __builtin_amdgcn_rcpf(1.f + __builtin_amdgcn_exp2f(-1.4426950408889634f * x)); }
__device__ __forceinline__ float fast_silu(float x) { return x * fast_sigmoid(x); }
__device__ __forceinline__ float gelu_tanh(float x) { const float c = 0.7978845608028654f; return 0.5f * x * (1.f + tanhf(c * (x + 0.044715f * x * x * x))); }
__device__ __forceinline__ float fast_gelu_tanh(float x) { const float c2 = 1.5957691216057308f; return x * fast_sigmoid(c2 * (x + 0.044715f * x * x * x)); }

constexpr int DM = 1024, NTOK_I = 4096, NTOK = 12288, DIN = 3072;
constexpr int NKROWS = 4096 + 8 * 1280;
constexpr float EPS = 1e-6f, LAM_INIT = 0.2f;
constexpr size_t O_YP = 0, O_YS = 4194304, O_NK = 12582912, O_NV = 14680064, O_NS = 16777216;

constexpr size_t MiB = 1u << 20;
constexpr size_t WS_CTL = 0, CTL_ZERO_BYTES = 256 * 1024;
constexpr size_t WS_MOD = 1 * MiB + 128 * 1024;
constexpr size_t WS_MISC = 1 * MiB;
constexpr size_t WS_ROPE = WS_MISC + 1024;
constexpr size_t WS_WIN = 2 * MiB;
constexpr size_t WS_WGLU = 8 * MiB;
constexpr size_t WS_WOUT = 9 * MiB;
constexpr size_t WS_XN = 12 * MiB;
constexpr size_t WS_Q = 36 * MiB;
constexpr size_t WS_K = 48 * MiB;
constexpr size_t WS_V = 62 * MiB;
constexpr size_t WS_GA = 76 * MiB;
constexpr size_t WS_U = 88 * MiB;
constexpr size_t WS_GS = 100 * MiB;
constexpr size_t WS_YS = 112 * MiB;
constexpr size_t WS_CAT = 124 * MiB;
constexpr size_t WS_OUT = 148 * MiB;
constexpr size_t WS_YF = 196 * MiB;
constexpr size_t WS_YB = 220 * MiB;
constexpr size_t WS_SSMW = 244 * MiB;
constexpr size_t WS_SIDE = 1 * MiB + 64 * 1024;
constexpr size_t WS_END = 256 * MiB;
static_assert(WS_ROPE + 8192 <= WS_SIDE && WS_SIDE + 65536 <= WS_MOD && WS_MOD + 8 * 9 * 3072 * 4 <= WS_WIN, "small-table map");

__device__ __forceinline__ int mod_index(int m) { return m < NTOK_I ? 0 : 1 + ((m - NTOK_I) >> 10); }
__device__ __forceinline__ int key_row(int m) { return m < NTOK_I ? m : 4096 + ((m - NTOK_I) >> 10) * 1280 + 256 + ((m - NTOK_I) & 1023); }
namespace pg8 {
#define PG8_LAS __attribute__((address_space(3)))
typedef unsigned short bf16_t;
typedef short bf16x8 __attribute__((ext_vector_type(8)));
typedef float f32x4 __attribute__((ext_vector_type(4)));
typedef unsigned u32x4 __attribute__((ext_vector_type(4)));
constexpr int BM = 256, BK = 64, HALF = 128, HTB = HALF * BK * 2  , STAGE_BYTES = 8 * HTB, NXCD = 8, WGM = 8;

__host__ __device__ __forceinline__ int lds_byte(int r, int c) { const int st = (r >> 4) * 2 + (c >> 5), rr = r & 15, cc = c & 31, ob = rr * 64 + cc * 2; return st * 1024 + (ob ^ (((ob >> 9) & 1) << 5)); }
__host__ __device__ __forceinline__ void stage_rc(int b, int& R, int& C) { const int st = b / 1024, sb = b % 1024, swz = sb ^ (((sb >> 9) & 1) << 5); R = (st >> 1) * 16 + swz / 64; C = (st & 1) * 32 + (swz % 64) / 2; }
__host__ __device__ __forceinline__ int perm32(int rho) { const int n = rho >> 4, i = rho & 15; return 8 * (i >> 2) + 4 * n + (i & 3); }

struct Unit { int pm, pn; };
struct Gemm { const bf16_t* A; const bf16_t* Bt; int M, N, K; };

struct StaticOrder {
    int nM, nN, nwg, G, c;
    __host__ __device__ void init(int M, int N, int G_, int c_) { nM = M / BM; nN = N / BM; nwg = nM * nN; G = G_; c = c_; }
    __host__ __device__ bool next(int i, Unit& u) const {
        const long L = (long)i * G + c; if (L >= nwg) return false;
        int wgid = (int)L; { const int q = nwg / NXCD, r = nwg % NXCD, xcd = wgid % NXCD, off = wgid / NXCD; wgid = (xcd < r ? xcd * (q + 1) : r * (q + 1) + (xcd - r) * q) + off; }
        const int nig = WGM * nN, gid = wgid / nig, fm = gid * WGM, gsz = (nM - fm) < WGM ? (nM - fm) : WGM;
        u.pm = fm + ((wgid % nig) % gsz); u.pn = (wgid % nig) / gsz; return true;
    }
    __device__ __forceinline__ void a_ready(const Unit&) const {}
    __device__ __forceinline__ void done(const Unit&) const {}
};

__device__ __forceinline__ unsigned cvt_pk_bf16(float lo, float hi) { unsigned r; asm volatile("v_cvt_pk_bf16_f32 %0, %1, %2" : "=v"(r) : "v"(lo), "v"(hi)); return r; }
typedef float f32x2 __attribute__((ext_vector_type(2)));
template <class Epi, class Sched, bool ALIGN_EPI = false, bool SP2 = false>
__device__ __forceinline__ void gemm_phase(PG8_LAS unsigned char* lds, const Gemm g, const Sched& S, const Epi& E) {
    int tid_ = threadIdx.x; asm volatile("" : "+v"(tid_));
    const int tid = tid_, wid = __builtin_amdgcn_readfirstlane(tid >> 6), lane = tid & 63, wr = wid >> 2, wc = wid & 3, fr = lane & 15, fq = lane >> 4;
    const int K = g.K, nt = K / BK;
    unsigned voffA[2], voffB[2];
#pragma unroll
    for (int i = 0; i < 2; ++i) { int R, C; stage_rc(tid * 16 + i * 8192, R, C); const int Rb = Epi::PERM ? ((R & ~31) + perm32(R & 31)) : R;
        voffA[i] = (unsigned)(R * K + C) * 2u; voffB[i] = (unsigned)(Rb * K + C) * 2u; }
    const size_t kstep = (size_t)(BK * 2);
    const size_t hstep = (size_t)HALF * K * 2;
    const size_t tstep = 2 * hstep;
    const unsigned ldsw = (unsigned)wid * 1024u;
    const int aoff = lds_byte(wr * 64 + fr, fq * 8), boff = lds_byte(wc * 32 + fr, fq * 8);
#define PG8_SA(b, h) (((b) * 2 + (h)) * HTB)
#define PG8_SB(b, h) ((4 + (b) * 2 + (h)) * HTB)
#define PG8_STAGE(bufoff, gbase, voff) do { _Pragma("unroll") for (int _i = 0; _i < 2; ++_i) \
        __builtin_amdgcn_global_load_lds((const unsigned*)((const char*)(gbase) + (voff)[_i]), (PG8_LAS unsigned*)(lds + (bufoff) + ldsw + _i * 8192), 16, 0, 0); } while (0)
#define PG8_LDA(dst, b, h) do { _Pragma("unroll") for (int m = 0; m < 4; ++m) _Pragma("unroll") for (int k = 0; k < 2; ++k) dst[m][k] = *(const PG8_LAS bf16x8*)(lds + PG8_SA(b, h) + aoff + m * 2048 + k * 1024); } while (0)
#define PG8_LDB(dst, b, h) do { _Pragma("unroll") for (int n = 0; n < 2; ++n) _Pragma("unroll") for (int k = 0; k < 2; ++k) dst[n][k] = *(const PG8_LAS bf16x8*)(lds + PG8_SB(b, h) + boff + n * 2048 + k * 1024); } while (0)
#define PG8_MMA(ai, bj, At, Bt) do { __builtin_amdgcn_s_setprio(1); _Pragma("unroll") for (int m = 0; m < 4; ++m) _Pragma("unroll") for (int n = 0; n < 2; ++n) _Pragma("unroll") for (int k = 0; k < 2; ++k) \
        acc[ai][bj][m][n] = __builtin_amdgcn_mfma_f32_16x16x32_bf16(Bt[n][k], At[m][k], acc[ai][bj][m][n], 0, 0, 0); __builtin_amdgcn_s_setprio(0); } while (0)
#define PG8_WAIT_V(n) asm volatile("s_waitcnt vmcnt(" #n ")" ::: "memory")
#define PG8_WAIT_L(n) asm volatile("s_waitcnt lgkmcnt(" #n ")" ::: "memory")
#define PG8_BAR __builtin_amdgcn_s_barrier()
#define PG8_SCHED __builtin_amdgcn_sched_barrier(0)
    Unit cur, nxt; int ui = 0;
    if (!S.next(0, cur)) return;
    f32x4 acc[2][2][4][2];
#pragma unroll
    for (int a = 0; a < 2; ++a)
#pragma unroll
        for (int b = 0; b < 2; ++b)
#pragma unroll
            for (int m = 0; m < 4; ++m)
#pragma unroll
                for (int n = 0; n < 2; ++n) acc[a][b][m][n] = (f32x4){0.f, 0.f, 0.f, 0.f};
    bf16x8 At[4][2], B0[2][2], B1[2][2];
    const char* cA = (const char*)g.A + (size_t)cur.pm * tstep; const char* cB = (const char*)g.Bt + (size_t)cur.pn * tstep;
    S.a_ready(cur);
    if constexpr (SP2) {
        PG8_STAGE(PG8_SB(0, 0), cB, voffB); PG8_STAGE(PG8_SB(0, 1), cB + hstep, voffB); PG8_STAGE(PG8_SA(0, 0), cA, voffA); PG8_STAGE(PG8_SA(0, 1), cA + hstep, voffA);
        if (wr == 1) PG8_BAR;
        PG8_WAIT_V(2); PG8_BAR;
        PG8_STAGE(PG8_SB(1, 0), cB + kstep, voffB); PG8_STAGE(PG8_SA(1, 0), cA + kstep, voffA); PG8_STAGE(PG8_SB(1, 1), cB + hstep + kstep, voffB);
        PG8_WAIT_V(6); PG8_BAR;
    } else {
        PG8_STAGE(PG8_SB(0, 0), cB, voffB); PG8_STAGE(PG8_SA(0, 0), cA, voffA); PG8_STAGE(PG8_SB(0, 1), cB + hstep, voffB); PG8_STAGE(PG8_SA(0, 1), cA + hstep, voffA);
        if (wr == 1) PG8_BAR;
        PG8_WAIT_V(4); PG8_BAR;
        PG8_STAGE(PG8_SB(1, 0), cB + kstep, voffB); PG8_STAGE(PG8_SA(1, 0), cA + kstep, voffA); PG8_STAGE(PG8_SB(1, 1), cB + hstep + kstep, voffB);
        PG8_WAIT_V(6); PG8_BAR;
    }
    for (;;) {
        const bool has_next = S.next(ui + 1, nxt);
        const char* nA = has_next ? (const char*)g.A + (size_t)nxt.pm * tstep : cA; const char* nB = has_next ? (const char*)g.Bt + (size_t)nxt.pn * tstep : cB;
        for (int t = 0; t < nt; t += 2) {
            const bool last = (t == nt - 2);
            const char* a1 = cA + (size_t)(t + 1) * kstep;
            const char* a2 = last ? nA : cA + (size_t)(t + 2) * kstep; const char* b2 = last ? nB : cB + (size_t)(t + 2) * kstep;
            const char* a3 = a2 + kstep; const char* b3 = b2 + kstep;
            if (last && has_next) S.a_ready(nxt);
            if constexpr (SP2) {
            PG8_LDB(B0, 0, 0); PG8_LDB(B1, 0, 1); PG8_SCHED; PG8_LDA(At, 0, 0); PG8_STAGE(PG8_SA(1, 1), a1 + hstep, voffA);
            PG8_WAIT_V(8); PG8_WAIT_L(0); PG8_BAR; PG8_MMA(0, 0, At, B0); PG8_MMA(0, 1, At, B1); PG8_BAR; PG8_SCHED;
            PG8_LDA(At, 0, 1); PG8_STAGE(PG8_SB(0, 0), b2, voffB); PG8_STAGE(PG8_SB(0, 1), b2 + hstep, voffB); PG8_STAGE(PG8_SA(0, 0), a2, voffA);
            PG8_WAIT_V(8); PG8_WAIT_L(0); PG8_BAR; PG8_MMA(1, 0, At, B0); PG8_MMA(1, 1, At, B1); PG8_BAR; PG8_SCHED;
            PG8_LDB(B0, 1, 0); PG8_LDB(B1, 1, 1); PG8_SCHED; PG8_LDA(At, 1, 0); PG8_STAGE(PG8_SA(0, 1), a2 + hstep, voffA);
            PG8_WAIT_V(8); PG8_WAIT_L(0); PG8_BAR; PG8_MMA(0, 0, At, B0); PG8_MMA(0, 1, At, B1); PG8_BAR; PG8_SCHED;
            PG8_LDA(At, 1, 1); PG8_STAGE(PG8_SB(1, 0), b3, voffB); PG8_STAGE(PG8_SB(1, 1), b3 + hstep, voffB); PG8_STAGE(PG8_SA(1, 0), a3, voffA);
            PG8_WAIT_V(8); PG8_WAIT_L(0); PG8_BAR; PG8_MMA(1, 0, At, B0); PG8_MMA(1, 1, At, B1); PG8_BAR; PG8_SCHED;
            } else {
            PG8_LDB(B0, 0, 0); PG8_SCHED; PG8_LDA(At, 0, 0); PG8_STAGE(PG8_SA(1, 1), a1 + hstep, voffA);
            PG8_WAIT_L(8); PG8_BAR; PG8_WAIT_L(0); PG8_MMA(0, 0, At, B0); PG8_BAR; PG8_SCHED;
            PG8_LDB(B1, 0, 1); PG8_STAGE(PG8_SB(0, 0), b2, voffB);
            PG8_BAR; PG8_WAIT_L(0); PG8_MMA(0, 1, At, B1); PG8_BAR;
            PG8_LDA(At, 0, 1); PG8_STAGE(PG8_SA(0, 0), a2, voffA);
            PG8_BAR; PG8_WAIT_L(0); PG8_MMA(1, 0, At, B0); PG8_BAR; PG8_SCHED;
            PG8_STAGE(PG8_SB(0, 1), b2 + hstep, voffB);
            PG8_WAIT_V(6); PG8_BAR; PG8_MMA(1, 1, At, B1); PG8_BAR;
            PG8_LDB(B0, 1, 0); PG8_SCHED; PG8_LDA(At, 1, 0); PG8_STAGE(PG8_SA(0, 1), a2 + hstep, voffA);
            PG8_WAIT_L(8); PG8_BAR; PG8_WAIT_L(0); PG8_MMA(0, 0, At, B0); PG8_BAR; PG8_SCHED;
            PG8_LDB(B1, 1, 1); PG8_STAGE(PG8_SB(1, 0), b3, voffB);
            PG8_BAR; PG8_WAIT_L(0); PG8_MMA(0, 1, At, B1); PG8_BAR;
            PG8_LDA(At, 1, 1); PG8_STAGE(PG8_SA(1, 0), a3, voffA);
            PG8_BAR; PG8_WAIT_L(0); PG8_MMA(1, 0, At, B0); PG8_BAR; PG8_SCHED;
            PG8_STAGE(PG8_SB(1, 1), b3 + hstep, voffB);
            PG8_WAIT_V(6); PG8_BAR; PG8_MMA(1, 1, At, B1); PG8_BAR;
            }
        }
        if constexpr (ALIGN_EPI) { if (wr == 0) PG8_BAR; }
        if constexpr (!Epi::AFTER_DRAIN) { E(acc, cur, wr, wc, fr, fq); S.done(cur); }
        if (!has_next) break;
#pragma unroll
        for (int a = 0; a < 2; ++a)
#pragma unroll
            for (int b = 0; b < 2; ++b)
#pragma unroll
                for (int m = 0; m < 4; ++m)
#pragma unroll
                    for (int n = 0; n < 2; ++n) acc[a][b][m][n] = (f32x4){0.f, 0.f, 0.f, 0.f};
        cur = nxt; cA = nA; cB = nB; ++ui;
        if constexpr (ALIGN_EPI) { if (wr == 1) PG8_BAR; }
    }
    PG8_WAIT_V(0);
    if constexpr (!ALIGN_EPI) { if (wr == 0) PG8_BAR; }
    PG8_BAR;
    if constexpr (Epi::AFTER_DRAIN) { E.fused(acc, cur, wr, wc, fr, fq, lds, wid, lane); S.done(cur); }
#undef PG8_SA
#undef PG8_SB
#undef PG8_STAGE
#undef PG8_LDA
#undef PG8_LDB
#undef PG8_MMA
#undef PG8_WAIT_V
#undef PG8_WAIT_L
#undef PG8_BAR
#undef PG8_SCHED
}
}
#define XB_TMO      128
#define XB_XCNT(j)  (256  + 64 * (j))
#define XB_XSUB(j)  (1280 + 64 * (j))
#define XB_XGEN(j)  (2304 + 64 * (j))
#define XB_TOP      3328
#define XB_TOPGEN   3392
#define XCD_BAR_WORDS 3456
#define XB_SPIN_CAP (1u << 18)

__device__ __forceinline__ unsigned xb_ld(unsigned* p)              { return __hip_atomic_load(p, __ATOMIC_RELAXED, __HIP_MEMORY_SCOPE_AGENT); }
__device__ __forceinline__ unsigned xb_add(unsigned* p, unsigned v) { return __hip_atomic_fetch_add(p, v, __ATOMIC_RELAXED, __HIP_MEMORY_SCOPE_AGENT); }
__device__ __forceinline__ unsigned xb_xcc_id() { return (unsigned)__builtin_amdgcn_s_getreg((3 << 11) | 20) & 0xFu; }
#define XB_SPIN(cond, bar) do { unsigned _sp = 0; while (cond) { __builtin_amdgcn_s_sleep(1); \
    if ((++_sp & 255u) == 0u) { if (xb_ld(&(bar)[XB_TMO])) break; if (_sp > XB_SPIN_CAP) { atomicAdd(&(bar)[XB_TMO], 1u); break; } } } } while (0)

struct XcdBarrier {
    unsigned* bar; unsigned x;
    volatile LAS unsigned* st;
};

__device__ __forceinline__ XcdBarrier xcd_barrier_post(unsigned* bar, volatile LAS unsigned* st) {
    XcdBarrier b; b.bar = bar; b.x = xb_xcc_id(); b.st = st;
    if (threadIdx.x == 0) (void)xb_add(&bar[XB_XCNT(b.x)], 1u);
    return b;
}
__device__ __forceinline__ void xcd_barrier_complete(unsigned* bar, unsigned x, unsigned& nloc, unsigned& nx) {
    const unsigned G = gridDim.x * gridDim.y * gridDim.z;
    unsigned sum, cnt, mine, sp = 0u;
    for (;;) {
        sum = 0u; cnt = 0u; mine = 0u;
#pragma unroll
        for (unsigned j = 0; j < 16; ++j) { const unsigned c = xb_ld(&bar[XB_XCNT(j)]); sum += c; cnt += (c > 0u) ? 1u : 0u; mine = (j == x) ? c : mine; }
        if (sum == G) break;
        __builtin_amdgcn_s_sleep(1);
        if ((++sp & 255u) == 0u) { if (xb_ld(&bar[XB_TMO])) break; if (sp > XB_SPIN_CAP) { atomicAdd(&bar[XB_TMO], 1u); break; } }
    }
    nloc = mine > 0u ? mine : 1u; nx = cnt > 0u ? cnt : 1u;
}

__device__ __forceinline__ void xcd_barrier(const XcdBarrier& b) {
    asm volatile("s_waitcnt vmcnt(0)" ::: "memory");
    __syncthreads();
    if (threadIdx.x == 0) {
        unsigned* bar = b.bar;
        __builtin_amdgcn_s_waitcnt(0);
        unsigned nloc = b.st[0], nx = b.st[1];
        if (nloc == 0u) { xcd_barrier_complete(bar, b.x, nloc, nx); b.st[0] = nloc; b.st[1] = nx; }
        const unsigned old = xb_add(&bar[XB_XSUB(b.x)], 1u);
        const unsigned gen = old / nloc;
        if (old + 1u == (gen + 1u) * nloc) {
            __builtin_amdgcn_fence(__ATOMIC_RELEASE, "agent");
            asm volatile("s_waitcnt vmcnt(0)" ::: "memory");
            const unsigned og = xb_add(&bar[XB_TOP], 1u);
            const unsigned tg = og / nx;
            if (og + 1u == (tg + 1u) * nx) xb_add(&bar[XB_TOPGEN], 1u);
            else XB_SPIN(xb_ld(&bar[XB_TOPGEN]) == tg, bar);
            __builtin_amdgcn_fence(__ATOMIC_ACQUIRE, "agent");
            xb_add(&bar[XB_XGEN(b.x)], 1u);
            asm volatile("s_waitcnt vmcnt(0)" ::: "memory");
        } else {
            XB_SPIN(xb_ld(&bar[XB_XGEN(b.x)]) == gen, bar);
            __builtin_amdgcn_fence(__ATOMIC_ACQUIRE, "agent");
            asm volatile("s_waitcnt vmcnt(0)" ::: "memory");
        }
    }
    __syncthreads();
}

namespace att {
using s16x4  = __attribute__((ext_vector_type(4))) short;
using f32x16 = __attribute__((ext_vector_type(16))) float;
using u32x4  = __attribute__((ext_vector_type(4))) unsigned;
constexpr int QBLK = 32, KVBLK = 64, LDK = 512, LDQ = 512;
constexpr float SCALE = 0.125f, THR = 8.f;
constexpr size_t SHM_V = KVBLK * 128 * 2, SHM_K = KVBLK * 128 * 2, SHM_ATTN = 2 * SHM_V + 2 * SHM_K + 8 * 64 * 4;
#define KSWZ(row, colB) ((row) * 256 + ((colB) ^ (((row) & 7) << 4)))
#define SBAR() __builtin_amdgcn_sched_barrier(0)
__device__ __forceinline__ int crow(int r, int hi) { return (r & 3) + 8 * (r >> 2) + 4 * hi; }
__device__ __forceinline__ unsigned cvtpk(float lo, float hi) { unsigned r; asm volatile("v_cvt_pk_bf16_f32 %0, %1, %2" : "=v"(r) : "v"(lo), "v"(hi)); return r; }
__device__ __forceinline__ bf16x8 ld8(const bf16_t* p) { return *reinterpret_cast<const bf16x8*>(p); }

__device__ __forceinline__ void partialSM(f32x16& p0, f32x16& p1, float& m_reg, float& mn, float& alpha) {
  constexpr float C = SCALE * 1.4426950408889634f;
  float pmax = p0[0]; for (int r = 1; r < 16; ++r) pmax = fmaxf(pmax, p0[r]); for (int r = 0; r < 16; ++r) pmax = fmaxf(pmax, p1[r]);
  { auto rr = __builtin_amdgcn_permlane32_swap(__float_as_uint(pmax), __float_as_uint(pmax), false, false);
    pmax = fmaxf(__uint_as_float(rr[0]), __uint_as_float(rr[1])); }
  if (__builtin_expect(__all(pmax - m_reg <= THR / SCALE), 1)) { mn = m_reg; alpha = 1.f; }
  else { mn = fmaxf(m_reg, pmax); alpha = __builtin_amdgcn_exp2f((m_reg - mn) * C); m_reg = mn; }
  float mnC = -mn * C;
  for (int r = 0; r < 16; ++r) p0[r] = fmaf(p0[r], C, mnC); for (int r = 0; r < 16; ++r) p1[r] = fmaf(p1[r], C, mnC);
  for (int r = 0; r < 16; ++r) p0[r] = __builtin_amdgcn_exp2f(p0[r]);
}
__device__ __forceinline__ void finishSM(f32x16& p0, f32x16& p1, float alpha, float& l_reg, bf16x8& pa0, bf16x8& pa1, bf16x8& pa2, bf16x8& pa3) {
  for (int r = 0; r < 16; ++r) p1[r] = __builtin_amdgcn_exp2f(p1[r]);
  float ps = 0; for (int r = 0; r < 16; ++r) ps += p0[r]; for (int r = 0; r < 16; ++r) ps += p1[r];
  { auto rr = __builtin_amdgcn_permlane32_swap(__float_as_uint(ps), __float_as_uint(ps), false, false);
    ps = __uint_as_float(rr[0]) + __uint_as_float(rr[1]); }
  l_reg = l_reg * alpha + ps;
#define PK4(P, BASE, OUT) do { unsigned a0 = cvtpk(P[BASE + 0], P[BASE + 1]), a1 = cvtpk(P[BASE + 2], P[BASE + 3]);   \
    unsigned b0 = cvtpk(P[BASE + 4], P[BASE + 5]), b1 = cvtpk(P[BASE + 6], P[BASE + 7]);                              \
    auto r0 = __builtin_amdgcn_permlane32_swap(a0, b0, false, false); auto r1 = __builtin_amdgcn_permlane32_swap(a1, b1, false, false); \
    u32x4 w = {r0[0], r1[0], r0[1], r1[1]}; OUT = *reinterpret_cast<bf16x8*>(&w); } while (0)
  PK4(p0, 0, pa0); PK4(p0, 8, pa1); PK4(p1, 0, pa2); PK4(p1, 8, pa3);
#undef PK4
}
__device__ __forceinline__ void qkt(f32x16& p0, f32x16& p1, const bf16_t* Ks, const bf16x8* qr, int r32, int hi, int c) {
  p0 = f32x16{}; p1 = f32x16{};
#pragma unroll
  for (int d0 = 0; d0 < 4; ++d0) { int cb = (c * 64 + d0 * 16 + hi * 8) * 2;
    bf16x8 b0 = *reinterpret_cast<const bf16x8*>((const char*)Ks + KSWZ(r32, cb));
    bf16x8 b1 = *reinterpret_cast<const bf16x8*>((const char*)Ks + KSWZ(32 + r32, cb));
    p0 = __builtin_amdgcn_mfma_f32_32x32x16_bf16(b0, qr[d0], p0, 0, 0, 0);
    p1 = __builtin_amdgcn_mfma_f32_32x32x16_bf16(b1, qr[d0], p1, 0, 0, 0); }
}
__device__ __forceinline__ int v_st(int k, int c) { const int kk = (k & ~0xC) | ((k & 4) << 1) | ((k & 8) >> 1); return ((kk >> 3) * 4 + (c >> 5)) * 512 + ((kk & 7) * 32 + (c & 31)) * 2; }
__device__ __forceinline__ int v_rd_base(int lane) { return ((lane & 3) << 3) | (((lane >> 2) & 3) << 6) | (((lane >> 4) & 1) << 5) | (((lane >> 5) & 1) << 8); }
constexpr int v_rd_off(int d0, int ks, int half) { return d0 * 512 + ks * 4096 + half * 2048; }
template <int OFF> __device__ __forceinline__ s16x4 tr_read(int vb) {
  s16x4 r; asm volatile("ds_read_b64_tr_b16 %0, %1 offset:%2" : "=&v"(r) : "v"(vb), "i"(OFF) : "memory"); return r;
}
template <int D0> __device__ __forceinline__ void pv_one(f32x16& od, int vb, bf16x8 pa0, bf16x8 pa1, bf16x8 pa2, bf16x8 pa3) {
  const s16x4 l0 = tr_read<v_rd_off(D0, 0, 0)>(vb), h0 = tr_read<v_rd_off(D0, 0, 1)>(vb), l1 = tr_read<v_rd_off(D0, 1, 0)>(vb), h1 = tr_read<v_rd_off(D0, 1, 1)>(vb);
  const s16x4 l2 = tr_read<v_rd_off(D0, 2, 0)>(vb), h2 = tr_read<v_rd_off(D0, 2, 1)>(vb), l3 = tr_read<v_rd_off(D0, 3, 0)>(vb), h3 = tr_read<v_rd_off(D0, 3, 1)>(vb);
  asm volatile("s_waitcnt lgkmcnt(0)" ::: "memory"); SBAR();
#define PK(L, H) (bf16x8){L[0], L[1], L[2], L[3], H[0], H[1], H[2], H[3]}
  od = __builtin_amdgcn_mfma_f32_32x32x16_bf16(pa0, PK(l0, h0), od, 0, 0, 0);
  od = __builtin_amdgcn_mfma_f32_32x32x16_bf16(pa1, PK(l1, h1), od, 0, 0, 0);
  od = __builtin_amdgcn_mfma_f32_32x32x16_bf16(pa2, PK(l2, h2), od, 0, 0, 0);
  od = __builtin_amdgcn_mfma_f32_32x32x16_bf16(pa3, PK(l3, h3), od, 0, 0, 0);
#undef PK
}
__device__ __forceinline__ void pv_d0(f32x16* o, int vb, bf16x8 pa0, bf16x8 pa1, bf16x8 pa2, bf16x8 pa3) {
  pv_one<0>(o[0], vb, pa0, pa1, pa2, pa3); pv_one<1>(o[1], vb, pa0, pa1, pa2, pa3); pv_one<2>(o[2], vb, pa0, pa1, pa2, pa3); pv_one<3>(o[3], vb, pa0, pa1, pa2, pa3);
}

__device__ __forceinline__ void attn_unit(const bf16_t* Qb, const bf16_t* Kh, const bf16_t* Vh, int seq, char* lds, float lam, const float* subln, const bf16_t* GAb, bf16_t* CATb, int nostore = 0) {
  int tid_ = threadIdx.x; asm volatile("" : "+v"(tid_));
  const int tid = tid_, wid = __builtin_amdgcn_readfirstlane(tid >> 6), lane = tid & 63, r32 = lane & 31, hi = lane >> 5, c = wid >> 2, wq = wid & 3;
  bf16_t* V_lds = (bf16_t*)lds; bf16_t* K_lds = (bf16_t*)(lds + 2 * SHM_V);
  float* ws = (float*)(lds + 2 * SHM_V + 2 * SHM_K) + wid * 64; float* li_l = ws; float* al_l = ws + 32;
  float m_reg = -1e30f, l_reg = 0; f32x16 o[4] = {}; bf16x8 qr[4];
  const bf16_t* Qw = Qb + (long)(wq * QBLK + r32) * LDQ + c * 64 + hi * 8;
#pragma unroll
  for (int d0 = 0; d0 < 4; ++d0) qr[d0] = ld8(Qw + d0 * 16);
  const int sr = tid >> 4, sc = (tid & 15) * 8, vst0 = v_st(sr, sc), vst1 = v_st(32 + sr, sc);
  const int vb0 = (int)(uintptr_t)V_lds + v_rd_base(lane);
  struct { bf16x8 vs0, vs1, ks0, ks1; } sr_[2];
#define SLOAD(i, k0) do { sr_[i].vs0 = ld8(&Vh[(long)((k0) + sr) * LDK + sc]); sr_[i].vs1 = ld8(&Vh[(long)((k0) + 32 + sr) * LDK + sc]); \
    sr_[i].ks0 = ld8(&Kh[(long)((k0) + sr) * LDK + sc]); sr_[i].ks1 = ld8(&Kh[(long)((k0) + 32 + sr) * LDK + sc]); } while (0)
#define SWRITE(b, i) do { *(bf16x8*)((char*)V_lds + (b) * SHM_V + vst0) = sr_[i].vs0;          \
    *(bf16x8*)((char*)V_lds + (b) * SHM_V + vst1) = sr_[i].vs1; int kc = sc * 2;               \
    *(bf16x8*)((char*)K_lds + (b) * SHM_K + KSWZ(sr, kc)) = sr_[i].ks0;                       \
    *(bf16x8*)((char*)K_lds + (b) * SHM_K + KSWZ(32 + sr, kc)) = sr_[i].ks1; } while (0)
#define SWAIT() asm volatile("s_waitcnt vmcnt(4)" ::: "memory")
#define RESC(a) do { if (__any((a) < 1.f)) { if (hi == 0) al_l[r32] = (a); asm volatile("s_waitcnt lgkmcnt(0)" ::: "memory"); \
    for (int d = 0; d < 4; ++d) for (int r = 0; r < 16; ++r) o[d][r] *= al_l[crow(r, hi)]; } } while (0)
  f32x16 pA0, pA1, pB0, pB1; float mnA, mnB, alA, alB; bf16x8 pa0, pa1, pa2, pa3; const int NT = seq / KVBLK;
  constexpr int SE = 0, SO = 1;
  SLOAD(SE, 0); asm volatile("s_waitcnt vmcnt(0)" ::: "memory"); SWRITE(0, SE); __syncthreads();
  qkt(pA0, pA1, K_lds, qr, r32, hi, c); partialSM(pA0, pA1, m_reg, mnA, alA);
  SLOAD(SO, KVBLK); if (2 < NT) SLOAD(SE, 2 * KVBLK);
  SWAIT(); SWRITE(1, SO); __syncthreads();
  for (int j = 1; j + 1 < NT; j += 2) {
    SBAR(); qkt(pB0, pB1, (bf16_t*)((char*)K_lds + SHM_K), qr, r32, hi, c);
    finishSM(pA0, pA1, alA, l_reg, pa0, pa1, pa2, pa3); SBAR();
    SLOAD(SO, (j + 2) * KVBLK); SBAR();
    pv_d0(o, vb0, pa0, pa1, pa2, pa3); partialSM(pB0, pB1, m_reg, mnB, alB);
    __syncthreads(); SWAIT(); SWRITE(0, SE);
    RESC(alB); __syncthreads();
    SBAR(); qkt(pA0, pA1, K_lds, qr, r32, hi, c);
    finishSM(pB0, pB1, alB, l_reg, pa0, pa1, pa2, pa3); SBAR();
    if (j + 3 < NT) SLOAD(SE, (j + 3) * KVBLK); SBAR();
    pv_d0(o, vb0 + (int)SHM_V, pa0, pa1, pa2, pa3); partialSM(pA0, pA1, m_reg, mnA, alA);
    __syncthreads(); SWAIT(); SWRITE(1, SO);
    RESC(alA); __syncthreads();
  }
  SBAR(); qkt(pB0, pB1, (bf16_t*)((char*)K_lds + SHM_K), qr, r32, hi, c);
  finishSM(pA0, pA1, alA, l_reg, pa0, pa1, pa2, pa3); SBAR();
  pv_d0(o, vb0, pa0, pa1, pa2, pa3); partialSM(pB0, pB1, m_reg, mnB, alB);
  __syncthreads(); RESC(alB);
  finishSM(pB0, pB1, alB, l_reg, pa0, pa1, pa2, pa3); SBAR();
  pv_d0(o, vb0 + (int)SHM_V, pa0, pa1, pa2, pa3);
  if (hi == 0) li_l[r32] = l_reg; asm volatile("s_waitcnt lgkmcnt(0)" ::: "memory");
  float rli[16];
#pragma unroll
  for (int r = 0; r < 16; ++r) rli[r] = __builtin_amdgcn_rcpf(li_l[crow(r, hi)]);
  __syncthreads();
  float* X = (float*)lds + (size_t)wq * (32 * 128);
  if (c == 1) {
#pragma unroll
    for (int r = 0; r < 16; ++r) { const int orow = crow(r, hi); const float f = rli[r] * lam;
#pragma unroll
      for (int d0 = 0; d0 < 4; ++d0) X[orow * 128 + d0 * 32 + r32] = o[d0][r] * f; }
  }
  __syncthreads();
  if (c == 0) {
#pragma unroll
    for (int r = 0; r < 16; ++r) { const int orow = crow(r, hi); float v[4]; float ss = 0.f;
#pragma unroll
      for (int d0 = 0; d0 < 4; ++d0) { v[d0] = o[d0][r] * rli[r] - X[orow * 128 + d0 * 32 + r32]; ss += v[d0] * v[d0]; }
#pragma unroll
      for (int s = 1; s < 32; s <<= 1) ss += __shfl_xor(ss, s);
      const float rs = rsqrtf(ss * (1.f / 128.f) + EPS) * (1.f - LAM_INIT);
#pragma unroll
      for (int d0 = 0; d0 < 4; ++d0) X[orow * 128 + d0 * 32 + r32] = v[d0] * rs; }
    asm volatile("s_waitcnt lgkmcnt(0)" ::: "memory");
    const int ch = lane & 15; float sg[8];
#pragma unroll
    for (int e = 0; e < 8; ++e) sg[e] = subln[ch * 8 + e];
#pragma unroll
    for (int it = 0; it < 8; ++it) { const int row = it * 4 + (lane >> 4); const long grow = (long)(wq * QBLK + row);
      const f32x4 x0 = *(const f32x4*)(X + row * 128 + ch * 8), x1 = *(const f32x4*)(X + row * 128 + ch * 8 + 4);
      const v4u g = *(const v4u*)(GAb + grow * 512 + ch * 8);
      v4u w; w.x = pk2(x0.x * sg[0] * bflo(g.x), x0.y * sg[1] * bfhi(g.x)); w.y = pk2(x0.z * sg[2] * bflo(g.y), x0.w * sg[3] * bfhi(g.y));
      w.z = pk2(x1.x * sg[4] * bflo(g.z), x1.y * sg[5] * bfhi(g.z)); w.w = pk2(x1.z * sg[6] * bflo(g.w), x1.w * sg[7] * bfhi(g.w));
      if (!nostore) *(v4u*)(CATb + grow * 1024 + ch * 8) = w; }
  }
  __syncthreads();
#undef SLOAD
#undef SWRITE
#undef SWAIT
#undef RESC
}
#undef KSWZ
#undef SBAR
}

namespace ssm {
using f32x16 = __attribute__((ext_vector_type(16))) float;
constexpr int SROW = 528;
constexpr size_t WA_ELEMS = 16 * 8 * 64 * 8, WC_ELEMS = 32 * 8 * 64 * 8, W_ELEMS = WA_ELEMS + WC_ELEMS;
constexpr int SIDE_F32 = 2 * 64 * 2 * 2;

struct Cplx { float re, im; };
__device__ __forceinline__ Cplx cmul(Cplx a, Cplx b) { return {a.re * b.re - a.im * b.im, a.re * b.im + a.im * b.re}; }

constexpr int NPART = 8;
__device__ __forceinline__ void precompute(int g, int part, const float* A_re, const float* A_im, const float* log_dt, const float* B_re, const float* B_im, const float* C_re, const float* C_im,
                                           const float* Dskip, bf16_t* W, float* side, LAS unsigned char* lds, int tid) {
    LAS float* apow = (LAS float*)lds;
    LAS float* bbar = (LAS float*)(lds + 17408);
    LAS float* Cc   = (LAS float*)(lds + 33792);
    LAS float* Kt   = (LAS float*)(lds + 50176);
    LAS float* Dl   = (LAS float*)(lds + 82944);
    LAS float* fz   = (LAS float*)(lds + 83008);
    if (tid < 128) { const int d = tid >> 6, p = tid & 63, dg = d * 32 + g;
        const float dt = expf(log_dt[dg]), Ar = A_re[dg * 64 + p], Ai = A_im[dg * 64 + p];
        const float mag = expf(Ar * dt); const Cplx ab = {mag * cosf(Ai * dt), mag * sinf(Ai * dt)};
        const float nr = ab.re - 1.f, ni = ab.im, den = Ar * Ar + Ai * Ai;
        fz[(d * 64 + p) * 2] = (nr * Ar + ni * Ai) / den; fz[(d * 64 + p) * 2 + 1] = (ni * Ar - nr * Ai) / den;
        Cplx pw = {1.f, 0.f};
        for (int m = 0; m <= 16; ++m) { apow[((d * 17 + m) * 64 + p) * 2] = pw.re; apow[((d * 17 + m) * 64 + p) * 2 + 1] = pw.im; if (m < 16) pw = cmul(pw, ab); }
        if (part == 0) { side[(d * 64 + p) * 2] = pw.re; side[(d * 64 + p) * 2 + 1] = pw.im;
            Cplx q = pw; for (int s = 0; s < 4; ++s) q = cmul(q, q);
            side[256 + (d * 64 + p) * 2] = q.re; side[256 + (d * 64 + p) * 2 + 1] = q.im; }
    }
    if (tid < 16) Dl[tid] = Dskip[g * 16 + tid];
    float br[4], bi[4];
#pragma unroll
    for (int j = 0; j < 4; ++j) { const int idx = tid + 512 * j, d = idx >> 10, rem = idx & 1023; const size_t o = (size_t)(d * 32 + g) * 1024 + rem;
        br[j] = B_re[o]; bi[j] = B_im[o]; Cc[idx * 2] = C_re[o]; Cc[idx * 2 + 1] = C_im[o]; }
    __syncthreads();
#pragma unroll
    for (int j = 0; j < 4; ++j) { const int idx = tid + 512 * j, dp = idx >> 4; const Cplx f = {fz[dp * 2], fz[dp * 2 + 1]}; const Cplx bb = cmul(f, (Cplx){br[j], bi[j]});
        bbar[idx * 2] = bb.re; bbar[idx * 2 + 1] = bb.im; }
    __syncthreads();
    { typedef float f32x4_t __attribute__((ext_vector_type(4)));
      const int wv = tid >> 6, l = tid & 63, d = wv >> 2, r16 = l & 15, q4 = l >> 4;
      bf16x8 bh[4], bl[4];
#pragma unroll
      for (int ks = 0; ks < 4; ++ks) { unsigned wh[4], wl[4];
#pragma unroll
          for (int q = 0; q < 4; ++q) { const int p = 16 * ks + 4 * q4 + q; const float u = bbar[((d * 64 + p) * 16 + r16) * 2], v = bbar[((d * 64 + p) * 16 + r16) * 2 + 1];
              const unsigned hu = f2bf(u), hv = f2bf(v); wh[q] = hu | (hv << 16); wl[q] = pk2(u - __uint_as_float(hu << 16), v - __uint_as_float(hv << 16)); }
          bh[ks] = __builtin_bit_cast(bf16x8, (v4u){wh[0], wh[1], wh[2], wh[3]}); bl[ks] = __builtin_bit_cast(bf16x8, (v4u){wl[0], wl[1], wl[2], wl[3]}); }
#pragma unroll 1
      for (int t = 0; t < 4; ++t) { const int m = 4 * (wv & 3) + t; f32x4_t acc = {0.f, 0.f, 0.f, 0.f};
#pragma unroll
          for (int ks = 0; ks < 4; ++ks) { unsigned wh[4], wl[4];
#pragma unroll
              for (int q = 0; q < 4; ++q) { const int p = 16 * ks + 4 * q4 + q; const Cplx c = {Cc[((d * 16 + r16) * 64 + p) * 2], Cc[((d * 16 + r16) * 64 + p) * 2 + 1]};
                  const Cplx a = {apow[((d * 17 + m) * 64 + p) * 2], apow[((d * 17 + m) * 64 + p) * 2 + 1]}; const Cplx z = cmul(c, a); const float u = z.re, v = -z.im;
                  const unsigned hu = f2bf(u), hv = f2bf(v); wh[q] = hu | (hv << 16); wl[q] = pk2(u - __uint_as_float(hu << 16), v - __uint_as_float(hv << 16)); }
              const bf16x8 ah = __builtin_bit_cast(bf16x8, (v4u){wh[0], wh[1], wh[2], wh[3]}), al = __builtin_bit_cast(bf16x8, (v4u){wl[0], wl[1], wl[2], wl[3]});
              acc = __builtin_amdgcn_mfma_f32_16x16x32_bf16(ah, bh[ks], acc, 0, 0, 0); acc = __builtin_amdgcn_mfma_f32_16x16x32_bf16(ah, bl[ks], acc, 0, 0, 0);
              acc = __builtin_amdgcn_mfma_f32_16x16x32_bf16(al, bh[ks], acc, 0, 0, 0); }
#pragma unroll
          for (int r = 0; r < 4; ++r) Kt[((d * 16 + m) * 16 + 4 * q4 + r) * 16 + r16] = acc[r]; } }
    __syncthreads();
    for (int o = part * (8192 / NPART) + tid; o < (part + 1) * (8192 / NPART); o += 512) { const int i = o >> 9, nt = (o >> 6) & 7, l = o & 63, d = nt >> 2, q = nt & 3, p = (l & 31) + 32 * (q >> 1), comp = q & 1, m = d == 0 ? 15 - i : i;
        const Cplx a = {apow[((d * 17 + m) * 64 + p) * 2], apow[((d * 17 + m) * 64 + p) * 2 + 1]};
        unsigned w[4];
#pragma unroll
        for (int e2 = 0; e2 < 4; ++e2) { float v[2];
#pragma unroll
            for (int t = 0; t < 2; ++t) { const int h = 8 * (l >> 5) + 2 * e2 + t; const Cplx b = {bbar[((d * 64 + p) * 16 + h) * 2], bbar[((d * 64 + p) * 16 + h) * 2 + 1]}; const Cplx z = cmul(a, b); v[t] = comp ? z.im : z.re; }
            w[e2] = pk2(v[0], v[1]); }
        *(GAS v4u*)(W + (size_t)o * 8) = (v4u){w[0], w[1], w[2], w[3]}; }
    for (int o = part * (16384 / NPART) + tid; o < (part + 1) * (16384 / NPART); o += 512) { const int ks = o >> 9, nt = (o >> 6) & 7, l = o & 63, cq = 32 * nt + (l & 31), j = cq >> 4, hp = cq & 15;
        unsigned w[4];
#pragma unroll
        for (int e2 = 0; e2 < 4; ++e2) { float v[2];
#pragma unroll
            for (int t = 0; t < 2; ++t) { const int e = 2 * e2 + t; float val;
                if (ks < 16) { const int i = ks, h = 8 * (l >> 5) + e; val = 0.f;
                    if (i <= j) val += Kt[((0 * 16 + (j - i)) * 16 + hp) * 16 + h];
                    if (i >= j) val += Kt[((1 * 16 + (i - j)) * 16 + hp) * 16 + h];
#ifndef SSM_PROBE
                    if (i == j && h == hp) val += Dl[h];
#endif
                    }
                else { const int kk = ks - 16, d = kk >> 3, kidx = 16 * (kk & 7) + 8 * (l >> 5) + e, p = kidx >> 1, comp = kidx & 1, m = d == 0 ? j + 1 : 16 - j;
                    const Cplx c = {Cc[((d * 16 + hp) * 64 + p) * 2], Cc[((d * 16 + hp) * 64 + p) * 2 + 1]};
                    const Cplx a = {apow[((d * 17 + m) * 64 + p) * 2], apow[((d * 17 + m) * 64 + p) * 2 + 1]};
                    const Cplx z = cmul(c, a); val = comp ? -z.im : z.re; }
                v[t] = val; }
            w[e2] = pk2(v[0], v[1]); }
        *(GAS v4u*)(W + WA_ELEMS + (size_t)o * 8) = (v4u){w[0], w[1], w[2], w[3]}; }
    __syncthreads();
}

template <int DIR, int KIND>
__device__ __forceinline__ void scan(const f32x16 (&x)[2][2], Cplx aT, Cplx aT16, Cplx h0, int hi, LAS unsigned char* SL, int col  , int mt0, Cplx (&fin)[2]) {
    Cplx cin[2];
    if (KIND == 1) {
        Cplx e[2];
#pragma unroll
        for (int m = 0; m < 2; ++m) { Cplx a = {0.f, 0.f};
#pragma unroll
            for (int s = 0; s < 16; ++s) { const int r = DIR ? 15 - s : s; const Cplx t = cmul(a, aT); a.re = t.re + x[m][0][r]; a.im = t.im + x[m][1][r]; }
            e[m] = a; }
        Cplx eo[2];
#pragma unroll
        for (int m = 0; m < 2; ++m) { eo[m].re = __shfl_xor(e[m].re, 32); eo[m].im = __shfl_xor(e[m].im, 32); }
        Cplx eA[2], eB[2];
#pragma unroll
        for (int m = 0; m < 2; ++m) { eA[m] = hi ? eo[m] : e[m]; eB[m] = hi ? e[m] : eo[m]; }
        Cplx c00, c01, c10, c11;
        if (DIR == 0) { c00 = h0; Cplx t = cmul(aT16, c00); c01 = {t.re + eA[0].re, t.im + eA[0].im}; t = cmul(aT16, c01); c10 = {t.re + eB[0].re, t.im + eB[0].im}; t = cmul(aT16, c10); c11 = {t.re + eA[1].re, t.im + eA[1].im}; }
        else { c11 = h0; Cplx t = cmul(aT16, c11); c10 = {t.re + eB[1].re, t.im + eB[1].im}; t = cmul(aT16, c10); c01 = {t.re + eA[1].re, t.im + eA[1].im}; t = cmul(aT16, c01); c00 = {t.re + eB[0].re, t.im + eB[0].im}; }
        cin[0] = hi ? c01 : c00; cin[1] = hi ? c11 : c10;
    } else { cin[0] = {0.f, 0.f}; cin[1] = {0.f, 0.f}; }
#pragma unroll
    for (int m = 0; m < 2; ++m) { Cplx s = cin[m];
#pragma unroll
        for (int q = 0; q < 16; ++q) { const int r = DIR ? 15 - q : q; const int rho = (r & 3) + 8 * (r >> 2) + 4 * hi;
            *(LAS unsigned*)(SL + ((mt0 + m) * 32 + rho) * 512 + ((((col >> 3) ^ (rho & 15)) << 4) | ((col & 7) * 2))) = pk2(s.re, s.im);
            const Cplx t = cmul(s, aT); s.re = t.re + x[m][0][r]; s.im = t.im + x[m][1][r]; }
        fin[m] = s; }
}

__device__ __forceinline__ int item_tok(int kind, int b0, int mt, int rho) { const int hr = (rho >> 2) & 1, rr = (rho & 3) + 4 * (rho >> 3);
    return kind ? NTOK_I + (b0 + (mt >> 1)) * 1024 + 16 * (32 * (mt & 1) + 16 * hr + rr) : (b0 + 2 * mt + hr) * 256 + 16 * rr; }
#define SSM_MMA4(ACC, A0, A1, B0, B1) do { \
        ACC[0][0] = __builtin_amdgcn_mfma_f32_32x32x16_bf16(A0, B0, ACC[0][0], 0, 0, 0); ACC[0][1] = __builtin_amdgcn_mfma_f32_32x32x16_bf16(A0, B1, ACC[0][1], 0, 0, 0); \
        ACC[1][0] = __builtin_amdgcn_mfma_f32_32x32x16_bf16(A1, B0, ACC[1][0], 0, 0, 0); ACC[1][1] = __builtin_amdgcn_mfma_f32_32x32x16_bf16(A1, B1, ACC[1][1], 0, 0, 0); } while (0)
__device__ __forceinline__ void item(int g, int kind, int b0, const bf16_t* U, const bf16_t* Wg, const float* side, const float* state_ssm, bf16_t* YS, float* out, LAS unsigned char* lds) {
    int tid_ = threadIdx.x; asm volatile("" : "+v"(tid_));
    const int tid = tid_, wid = __builtin_amdgcn_readfirstlane(tid >> 6), lane = tid & 63, r32 = lane & 31, hi = lane >> 5, mp = wid & 1, nq = wid >> 1;
    LAS unsigned char* UL = lds; LAS unsigned char* SL = lds + 65536;
    const bf16x8* WA = (const bf16x8*)Wg + 2 * nq * 64 + lane; const bf16x8* WC = (const bf16x8*)(Wg + WA_ELEMS) + 2 * nq * 64 + lane;
    {   v4u pc[8];
#pragma unroll
        for (int j = 0; j < 8; ++j) { const int id = tid + 512 * j, row = id >> 5, ch = id & 31;
            pc[j] = *(const GAS v4u*)(U + (size_t)(item_tok(kind, b0, row >> 5, row & 31) + (ch >> 1)) * 512 + g * 16 + (ch & 1) * 8); }
#pragma unroll
        for (int j = 0; j < 8; ++j) { const int id = tid + 512 * j, row = id >> 5, ch = id & 31; *(LAS v4u*)(UL + row * 512 + ((ch ^ (row & 15)) << 4)) = pc[j]; }
    }
    bf16x8 bq[4][2];
#pragma unroll
    for (int s4 = 0; s4 < 4; ++s4) { bq[s4][0] = WA[s4 * 512]; bq[s4][1] = WA[s4 * 512 + 64]; }
    __syncthreads();
    const LAS unsigned char* ua0 = UL + ((2 * mp) * 32 + r32) * 512; const LAS unsigned char* ua1 = ua0 + 32 * 512; const int sw = r32 & 15;
    f32x16 x[2][2];
#pragma unroll
    for (int m = 0; m < 2; ++m)
#pragma unroll
        for (int t = 0; t < 2; ++t) x[m][t] = f32x16{};
#define SSM_STEP(ACC, P0, P1, II, PREF) do { const bf16x8 a0 = *(const LAS bf16x8*)((P0) + (((2 * (II) + hi) ^ sw) << 4)), a1 = *(const LAS bf16x8*)((P1) + (((2 * (II) + hi) ^ sw) << 4)); \
        SSM_MMA4(ACC, a0, a1, bq[i & 3][0], bq[i & 3][1]); __builtin_amdgcn_sched_barrier(0); PREF; __builtin_amdgcn_sched_barrier(0); } while (0)
#pragma unroll 4
    for (int i = 0; i < 12; ++i) SSM_STEP(x, ua0, ua1, i, (bq[i & 3][0] = WA[(i + 4) * 512], bq[i & 3][1] = WA[(i + 4) * 512 + 64]));
#pragma unroll
    for (int i = 12; i < 16; ++i) SSM_STEP(x, ua0, ua1, i, (bq[i & 3][0] = WC[(i - 12) * 512], bq[i & 3][1] = WC[(i - 12) * 512 + 64]));
    { const int d = nq >> 1, p = r32 + 32 * (nq & 1);
      const Cplx aT = {side[(d * 64 + p) * 2], side[(d * 64 + p) * 2 + 1]}, aT16 = {side[256 + (d * 64 + p) * 2], side[256 + (d * 64 + p) * 2 + 1]};
      Cplx h0 = {0.f, 0.f};
      if (kind) { const size_t sb = ((size_t)((b0 + mp) * 2 + d) * 2) * 2048 + g * 64 + p; h0.re = state_ssm[sb]; h0.im = state_ssm[sb + 2048]; }
      Cplx fin[2];
      if (kind) { if (d == 0) scan<0, 1>(x, aT, aT16, h0, hi, SL, d * 128 + 2 * p, 2 * mp, fin); else scan<1, 1>(x, aT, aT16, h0, hi, SL, d * 128 + 2 * p, 2 * mp, fin); }
      else { if (d == 0) scan<0, 0>(x, aT, aT16, h0, hi, SL, d * 128 + 2 * p, 2 * mp, fin); else scan<1, 0>(x, aT, aT16, h0, hi, SL, d * 128 + 2 * p, 2 * mp, fin);
#pragma unroll
          for (int m = 0; m < 2; ++m) { const int b = b0 + 2 * (2 * mp + m) + hi; const size_t sb = ((size_t)(b * 2 + d) * 2) * 2048 + g * 64 + p; out[O_NS + sb] = fin[m].re; out[O_NS + sb + 2048] = fin[m].im; } }
    }
    __syncthreads();
    f32x16 y[2][2];
#pragma unroll
    for (int m = 0; m < 2; ++m)
#pragma unroll
        for (int t = 0; t < 2; ++t) y[m][t] = f32x16{};
    const LAS unsigned char* sa0 = SL + ((2 * mp) * 32 + r32) * 512; const LAS unsigned char* sa1 = sa0 + 32 * 512;
#pragma unroll 4
    for (int i = 0; i < 16; ++i) SSM_STEP(y, ua0, ua1, i, (bq[i & 3][0] = WC[(i + 4) * 512], bq[i & 3][1] = WC[(i + 4) * 512 + 64]));
#pragma unroll 4
    for (int i = 16; i < 28; ++i) SSM_STEP(y, sa0, sa1, i - 16, (bq[i & 3][0] = WC[(i + 4) * 512], bq[i & 3][1] = WC[(i + 4) * 512 + 64]));
#pragma unroll
    for (int i = 28; i < 32; ++i) SSM_STEP(y, sa0, sa1, i - 16, (void)0);
#undef SSM_STEP
    __syncthreads();
#pragma unroll
    for (int m = 0; m < 2; ++m)
#pragma unroll
        for (int r = 0; r < 16; ++r) { const int rho = (r & 3) + 8 * (r >> 2) + 4 * hi, row = (2 * mp + m) * 32 + rho;
#pragma unroll
            for (int t = 0; t < 2; ++t) { const int cq = 64 * nq + 32 * t + r32, ch = cq >> 3;
#ifdef SSM_PROBE
                { const int j = cq >> 4, hp = cq & 15; ((float*)YS)[(size_t)(item_tok(kind, b0, 2 * mp + m, rho) + j) * 512 + g * 16 + hp] = y[m][t][r]; }
#endif
                *(LAS bf16_t*)(UL + row * 512 + ((ch ^ (rho & 15)) << 4) + (cq & 7) * 2) = (bf16_t)f2bf(fast_gelu_tanh(y[m][t][r])); } }
    __syncthreads();
#ifndef SSM_PROBE
#pragma unroll
    for (int j = 0; j < 8; ++j) { const int id = tid + 512 * j, row = id >> 5, ch = id & 31;
        const v4u v = *(const LAS v4u*)(UL + row * 512 + ((ch ^ (row & 15)) << 4));
        *(GAS v4u*)(YS + (size_t)(item_tok(kind, b0, row >> 5, row & 31) + (ch >> 1)) * 512 + g * 16 + (ch & 1) * 8) = v; }
#endif
    __syncthreads();
}
#undef SSM_MMA4
}

constexpr int NWAVES = 8, NTHREADS = 512;
constexpr int RING_BYTES = 131072, LDSCTL_OFF = RING_BYTES, MISC_OFF = LDSCTL_OFF + 320, LDS_BYTES = 147456;
constexpr int CW_BAR = 4096;
static_assert((CW_BAR + XCD_BAR_WORDS) * 4 <= (int)CTL_ZERO_BYTES, "barrier words inside the memset region");
constexpr int NPHASE = 7;

struct Args { const float* in[25]; float* out; unsigned char* ws; int ph_lo, ph_hi; int rep[8]; int p3mask, pad; };

struct Frame {
    LAS unsigned char* lds; int tid, lane, wave, G;
    const float *x_prompt, *x_sample, *cache_k, *cache_v, *state_ssm, *c, *c_ctx, *w_ada, *b_ada, *norm_pre, *norm_post, *w_in, *lambda_qk, *subln;
    const float *A_re, *A_im, *log_dt, *B_re, *B_im, *C_re, *C_im, *ssm_D, *w_glu, *b_glu, *w_out;
    float* out; float *PART, *MISC, *ROPE, *OUT;
    bf16_t *WIN, *WGLU, *WOUT, *XN, *Q, *KALL, *VALL, *GA, *U, *GS, *YS, *CAT, *SSMW; float* SIDE;
};

__device__ __forceinline__ void p0_adaln_part(Frame& F, int wg) {
    const int kb = wg >> 5, cc = wg & 31;
    LAS float* sc = (LAS float*)F.lds;
    LAS float* red = (LAS float*)(F.lds + 8192);
    for (int i = F.tid; i < 9 * 128; i += NTHREADS) { const int ci = i >> 7, k = 128 * kb + (i & 127); const float v = ci == 0 ? F.c_ctx[k] : F.c[(ci - 1) * DM + k]; sc[i] = siluf(v); }
    __syncthreads();
    const int c4 = F.tid % 24, rg = F.tid / 24;
    if (rg < 21) {
        f32x4 w[7];
#pragma unroll
        for (int j = 0; j < 7; ++j) { const int r = rg + 21 * j; w[j] = r < 128 ? *(const GAS f32x4*)(F.w_ada + (size_t)(128 * kb + r) * DIN + 96 * cc + 4 * c4) : (f32x4){0.f, 0.f, 0.f, 0.f}; }
#pragma unroll
        for (int ci = 0; ci < 9; ++ci) { f32x4 a = {0.f, 0.f, 0.f, 0.f};
#pragma unroll
            for (int j = 0; j < 7; ++j) { const int r = rg + 21 * j; const float sv = r < 128 ? sc[ci * 128 + r] : 0.f; a += w[j] * sv; }
            *(LAS f32x4*)(red + (rg * 9 + ci) * 96 + 4 * c4) = a; }
    }
    __syncthreads();
    for (int o = F.tid; o < 9 * 96; o += NTHREADS) { float sum = 0.f;
#pragma unroll
        for (int r = 0; r < 21; ++r) sum += red[r * 864 + o];
        const int ci = o / 96, col = o % 96; F.PART[(size_t)(kb * 9 + ci) * DIN + 96 * cc + col] = sum; }
    __syncthreads();
}
__device__ __forceinline__ void mod_to_lds(Frame& F, LAS float* MODL, int ci0, int ci1, int col0, int n) {
    for (int i = F.tid; i < 2 * n; i += NTHREADS) { const int j = i >= n, col = col0 + (j ? i - n : i), ci = j ? ci1 : ci0; float sum = F.b_ada[col];
#pragma unroll
        for (int kb = 0; kb < 8; ++kb) sum += F.PART[(size_t)(kb * 9 + ci) * DIN + col];
        MODL[i] = sum; }
    __syncthreads();
}
__device__ __forceinline__ void p0_transpose_item(const float* W, int K, int N, bf16_t* WT, LAS float* scr, int item, int lane) {
    const int nblk = N / 32, kb = item / nblk, nb = item % nblk, k0 = 64 * kb, n0 = 32 * nb;
#pragma unroll 8
    for (int i = 0; i < 32; ++i) { const int kk = 2 * i + (lane >> 5); scr[kk * 33 + (lane & 31)] = W[(size_t)(k0 + kk) * N + n0 + (lane & 31)]; }
    LDS_WAIT(); asm volatile("" ::: "memory");
    const int c = lane & 7;
#pragma unroll
    for (int j = 0; j < 4; ++j) { const int n = (lane >> 3) + 8 * j; const LAS float* s = scr + (8 * c) * 33 + n;
        v4u o; o.x = pk2(s[0 * 33], s[1 * 33]); o.y = pk2(s[2 * 33], s[3 * 33]); o.z = pk2(s[4 * 33], s[5 * 33]); o.w = pk2(s[6 * 33], s[7 * 33]);
        *(GAS v4u*)(WT + (size_t)(n0 + n) * K + k0 + 8 * c) = o; }
    LDS_WAIT(); asm volatile("" ::: "memory");
}
__device__ __forceinline__ void p0_prologue(Frame& F, int pm) {
    const int wg = blockIdx.x;
    if (pm & 1) p0_adaln_part(F, wg);
    if ((pm & 2) && wg < 32 * ssm::NPART) { const int g = wg / ssm::NPART;
        ssm::precompute(g, wg % ssm::NPART, F.A_re, F.A_im, F.log_dt, F.B_re, F.B_im, F.C_re, F.C_im, F.ssm_D, F.SSMW + (size_t)g * ssm::W_ELEMS, F.SIDE + g * ssm::SIDE_F32, F.lds, F.tid); }
    if ((pm & 8) && wg == F.G - 1) {
        for (int t = F.tid; t < 1024; t += NTHREADS) { const int pos = t >> 4, f = t & 15; const float inv = powf(10000.f, -(float)f / 16.f), ang = (float)pos * inv;
            F.ROPE[pos * 16 + f] = cosf(ang); F.ROPE[1024 + pos * 16 + f] = sinf(ang); }
        if (F.tid == 0) { float s1 = 0.f, s2 = 0.f; for (int i = 0; i < 64; ++i) { s1 += F.lambda_qk[i] * F.lambda_qk[64 + i]; s2 += F.lambda_qk[128 + i] * F.lambda_qk[192 + i]; }
            F.MISC[0] = expf(s1) - expf(s2) + LAM_INIT; }
    }
    LAS float* scr = (LAS float*)(F.lds + F.wave * 16384);
    const int NGW = F.G * NWAVES, o = wg * NWAVES + F.wave;
    constexpr int I_IN = (DM / 64) * (DIN / 32), I_GLU = (512 / 64) * (512 / 32), I_OUT = (DM / 64) * (DM / 32), NITEMS = I_IN + I_GLU + I_OUT;
    if (pm & 4) for (int it = o; it < NITEMS; it += NGW) {
        int r = it;
        if (r < I_IN) { p0_transpose_item(F.w_in, DM, DIN, F.WIN, scr, r, F.lane); continue; } r -= I_IN;
        if (r < I_GLU) { p0_transpose_item(F.w_glu, 512, 512, F.WGLU, scr, r, F.lane); continue; } r -= I_GLU;
        p0_transpose_item(F.w_out, DM, DM, F.WOUT, scr, r, F.lane);
    }
    if (pm & 8) { const int n4 = 8 * 256 * 512 / 4;
        for (int i = wg * NTHREADS + F.tid; i < 2 * n4; i += F.G * NTHREADS) { const bool isv = i >= n4; const int j = isv ? i - n4 : i;
            const f32x4 v = ((const GAS f32x4*)(isv ? F.cache_v : F.cache_k))[j];
            const int b = j / (256 * 128), rem = j % (256 * 128); v2u w; w.x = pk2(v.x, v.y); w.y = pk2(v.z, v.w);
            ((GAS v2u*)((isv ? F.VALL : F.KALL) + (size_t)(4096 + b * 1280) * 512))[rem] = w; } }
}
__device__ __forceinline__ void p1_prep_x(Frame& F) {
    constexpr int RPB = NTOK / 256;
    const int row0 = blockIdx.x * RPB, ci0 = mod_index(row0), ci1 = mod_index(row0 + RPB - 1);
    LAS float* MODL = (LAS float*)F.lds;
    mod_to_lds(F, MODL, ci0, ci1, 0, 2048);
    for (int m = row0 + F.wave; m < row0 + RPB; m += NWAVES) {
        const float* xr = m < NTOK_I ? F.x_prompt + (size_t)m * DM : F.x_sample + (size_t)(m - NTOK_I) * DM;
        const LAS float* shift = MODL + (mod_index(m) == ci0 ? 0 : 2048); const LAS float* scale = shift + DM;
        f32x4 v[4]; float ss = 0.f;
#pragma unroll
        for (int j = 0; j < 4; ++j) { v[j] = ((const GAS f32x4*)xr)[F.lane + 64 * j]; ss += (v[j].x * v[j].x + v[j].y * v[j].y) + (v[j].z * v[j].z + v[j].w * v[j].w); }
        ss = wave_sum(ss); const float r = rsqrtf(ss * (1.f / DM) + EPS);
#pragma unroll
        for (int j = 0; j < 4; ++j) { const int i4 = F.lane + 64 * j;
            const f32x4 g = ((const GAS f32x4*)F.norm_pre)[i4], sc = ((const LAS f32x4*)scale)[i4], sh = ((const LAS f32x4*)shift)[i4];
            v2u o; o.x = pk2(v[j].x * r * g.x * (1.f + sc.x) + sh.x, v[j].y * r * g.y * (1.f + sc.y) + sh.y);
            o.y = pk2(v[j].z * r * g.z * (1.f + sc.z) + sh.z, v[j].w * r * g.w * (1.f + sc.w) + sh.w);
            ((GAS v2u*)(F.XN + (size_t)m * DM))[i4] = o; }
    }
    __syncthreads();
}
struct EpiIn {
    static constexpr bool PERM = false, AFTER_DRAIN = false;
    bf16_t *Q, *KALL, *VALL, *GA, *U, *GS; float* out; const float* ROPE;
    __device__ __forceinline__ void operator()(const pg8::f32x4 (&acc)[2][2][4][2], const pg8::Unit& u, int wr, int wc, int fr, int fq) const {
        const int sec = u.pn >> 1, cbase = (u.pn & 1) * 256 + wc * 32 + 4 * fq, rbase = u.pm * 256 + wr * 64 + fr;
        const bool g2 = u.pm >= 16, rope = g2 && sec < 2;
#pragma unroll
        for (int ai = 0; ai < 2; ++ai)
#pragma unroll
            for (int m = 0; m < 4; ++m) {
                const int r = rbase + 128 * ai + 16 * m;
                f32x4 cs = {1.f, 1.f, 1.f, 1.f}, sn = {0.f, 0.f, 0.f, 0.f};
                if (rope) { const int t = (r - NTOK_I) & 1023, pos = (wc & 1) ? (t & 63) : (t >> 6);
                    cs = *(const GAS f32x4*)(ROPE + pos * 16 + 4 * fq); sn = *(const GAS f32x4*)(ROPE + 1024 + pos * 16 + 4 * fq); }
                const size_t krow = (size_t)key_row(r);
#pragma unroll
                for (int bj = 0; bj < 2; ++bj) {
                    const f32x4 a0 = acc[ai][bj][m][0], a1 = acc[ai][bj][m][1];
                    const f32x4 v0 = a0 * cs - a1 * sn, v1 = a1 * cs + a0 * sn;
                    const int cc = cbase + 128 * bj;
                    if (sec == 0) { bf16_t* p = Q + (size_t)r * 512 + cc;
                        *(GAS v2u*)p = (v2u){pk2(v0.x, v0.y), pk2(v0.z, v0.w)}; *(GAS v2u*)(p + 16) = (v2u){pk2(v1.x, v1.y), pk2(v1.z, v1.w)}; }
                    else if (sec == 1 || sec == 2) { bf16_t* p = (sec == 1 ? KALL : VALL) + krow * 512 + cc;
                        *(GAS v2u*)p = (v2u){pk2(v0.x, v0.y), pk2(v0.z, v0.w)}; *(GAS v2u*)(p + 16) = (v2u){pk2(v1.x, v1.y), pk2(v1.z, v1.w)};
                        if (!g2) { float* o = out + (sec == 1 ? O_NK : O_NV) + (size_t)r * 512 + cc; *(GAS f32x4*)o = v0; *(GAS f32x4*)(o + 16) = v1; } }
                    else if (sec == 4) { bf16_t* p = U + (size_t)r * 512 + cc;
                        *(GAS v2u*)p = (v2u){pk2(v0.x, v0.y), pk2(v0.z, v0.w)}; *(GAS v2u*)(p + 16) = (v2u){pk2(v1.x, v1.y), pk2(v1.z, v1.w)}; }
                    else { bf16_t* p = (sec == 3 ? GA : GS) + (size_t)r * 512 + cc;
                        *(GAS v2u*)p = (v2u){pk2(fast_silu(v0.x), fast_silu(v0.y)), pk2(fast_silu(v0.z), fast_silu(v0.w))};
                        *(GAS v2u*)(p + 16) = (v2u){pk2(fast_silu(v1.x), fast_silu(v1.y)), pk2(fast_silu(v1.z), fast_silu(v1.w))}; }
                }
            }
    }
};

struct EpiGlu {
    static constexpr bool PERM = true, AFTER_DRAIN = false;
    const bf16_t *YS, *GS; const float* b_glu; bf16_t* CAT;
    __device__ __forceinline__ void operator()(const pg8::f32x4 (&acc)[2][2][4][2], const pg8::Unit& u, int wr, int wc, int fr, int fq) const {
        const int cbase = u.pn * 256 + wc * 32 + 8 * fq, rbase = u.pm * 256 + wr * 64 + fr;
#pragma unroll
        for (int bj = 0; bj < 2; ++bj) { const int c = cbase + 128 * bj;
            const f32x4 b0 = *(const GAS f32x4*)(b_glu + c), b1 = *(const GAS f32x4*)(b_glu + c + 4);
#pragma unroll
            for (int ai = 0; ai < 2; ++ai)
#pragma unroll
                for (int m = 0; m < 4; ++m) { const size_t r = (size_t)(rbase + 128 * ai + 16 * m);
                    const v4u y = *(const GAS v4u*)(YS + r * 512 + c), g = *(const GAS v4u*)(GS + r * 512 + c);
                    const f32x4 a0 = acc[ai][bj][m][0] + b0, a1 = acc[ai][bj][m][1] + b1;
                    v4u o;
                    o.x = pk2(bflo(y.x) * fast_sigmoid(a0.x) * bflo(g.x), bfhi(y.x) * fast_sigmoid(a0.y) * bfhi(g.x));
                    o.y = pk2(bflo(y.y) * fast_sigmoid(a0.z) * bflo(g.y), bfhi(y.y) * fast_sigmoid(a0.w) * bfhi(g.y));
                    o.z = pk2(bflo(y.z) * fast_sigmoid(a1.x) * bflo(g.z), bfhi(y.z) * fast_sigmoid(a1.y) * bfhi(g.z));
                    o.w = pk2(bflo(y.w) * fast_sigmoid(a1.z) * bflo(g.w), bfhi(y.w) * fast_sigmoid(a1.w) * bfhi(g.w));
                    *(GAS v4u*)(CAT + r * 1024 + 512 + c) = o; } }
    }
};
struct EpiOut {
    static constexpr bool PERM = false, AFTER_DRAIN = false;
    float* OUT;
    __device__ __forceinline__ void operator()(const pg8::f32x4 (&acc)[2][2][4][2], const pg8::Unit& u, int wr, int wc, int fr, int fq) const {
        const int cbase = u.pn * 256 + wc * 32 + 4 * fq, rbase = u.pm * 256 + wr * 64 + fr;
#pragma unroll
        for (int ai = 0; ai < 2; ++ai)
#pragma unroll
            for (int m = 0; m < 4; ++m) { float* o = OUT + (size_t)(rbase + 128 * ai + 16 * m) * 1024 + cbase;
#pragma unroll
                for (int bj = 0; bj < 2; ++bj) { *(GAS f32x4*)(o + 128 * bj) = acc[ai][bj][m][0]; *(GAS f32x4*)(o + 128 * bj + 16) = acc[ai][bj][m][1]; } }
    }
};
__device__ __forceinline__ void p6_final(Frame& F) {
    constexpr int RPB = NTOK / 256;
    const int row0 = blockIdx.x * RPB, ci0 = mod_index(row0), ci1 = mod_index(row0 + RPB - 1);
    LAS float* MODL = (LAS float*)F.lds;
    mod_to_lds(F, MODL, ci0, ci1, 2048, 1024);
    for (int m = row0 + F.wave; m < row0 + RPB; m += NWAVES) {
        const float* xr = m < NTOK_I ? F.x_prompt + (size_t)m * DM : F.x_sample + (size_t)(m - NTOK_I) * DM;
        const LAS float* gate = MODL + (mod_index(m) == ci0 ? 0 : 1024); const float* orow = F.OUT + (size_t)m * DM;
        f32x4 v[4]; float ss = 0.f;
#pragma unroll
        for (int j = 0; j < 4; ++j) { v[j] = ((const GAS f32x4*)orow)[F.lane + 64 * j]; ss += (v[j].x * v[j].x + v[j].y * v[j].y) + (v[j].z * v[j].z + v[j].w * v[j].w); }
        ss = wave_sum(ss); const float r = rsqrtf(ss * (1.f / DM) + EPS);
#pragma unroll
        for (int j = 0; j < 4; ++j) { const int i4 = F.lane + 64 * j;
            const f32x4 g = ((const GAS f32x4*)F.norm_post)[i4], ga = ((const LAS f32x4*)gate)[i4], x = ((const GAS f32x4*)xr)[i4];
            ((GAS f32x4*)(F.out + (size_t)m * DM))[i4] = x + ga * (v[j] * r) * g; }
    }
    __syncthreads();
}

__global__ void __launch_bounds__(NTHREADS, 2) mega(Args args) {
    extern __shared__ __attribute__((aligned(16))) unsigned char lds_raw[];
    Frame F;
    F.lds = (LAS unsigned char*)lds_raw; F.tid = threadIdx.x; F.lane = F.tid & 63; F.wave = __builtin_amdgcn_readfirstlane(F.tid >> 6); F.G = gridDim.x;
    volatile LAS unsigned* MISCL = (volatile LAS unsigned*)(F.lds + MISC_OFF);
    unsigned char* ws = args.ws;
    F.x_prompt = args.in[0]; F.x_sample = args.in[1]; F.cache_k = args.in[2]; F.cache_v = args.in[3]; F.state_ssm = args.in[4]; F.c = args.in[5]; F.c_ctx = args.in[6];
    F.w_ada = args.in[7]; F.b_ada = args.in[8]; F.norm_pre = args.in[9]; F.norm_post = args.in[10]; F.w_in = args.in[11]; F.lambda_qk = args.in[12]; F.subln = args.in[13];
    F.A_re = args.in[14]; F.A_im = args.in[15]; F.log_dt = args.in[16]; F.B_re = args.in[17]; F.B_im = args.in[18]; F.C_re = args.in[19]; F.C_im = args.in[20];
    F.ssm_D = args.in[21]; F.w_glu = args.in[22]; F.b_glu = args.in[23]; F.w_out = args.in[24]; F.out = args.out;
    F.PART = (float*)(ws + WS_MOD); F.MISC = (float*)(ws + WS_MISC); F.ROPE = (float*)(ws + WS_ROPE); F.OUT = (float*)(ws + WS_OUT);
    F.WIN = (bf16_t*)(ws + WS_WIN); F.WGLU = (bf16_t*)(ws + WS_WGLU); F.WOUT = (bf16_t*)(ws + WS_WOUT); F.XN = (bf16_t*)(ws + WS_XN); F.Q = (bf16_t*)(ws + WS_Q);
    F.KALL = (bf16_t*)(ws + WS_K); F.VALL = (bf16_t*)(ws + WS_V); F.GA = (bf16_t*)(ws + WS_GA); F.U = (bf16_t*)(ws + WS_U); F.GS = (bf16_t*)(ws + WS_GS);
    F.YS = (bf16_t*)(ws + WS_YS); F.CAT = (bf16_t*)(ws + WS_CAT); F.SSMW = (bf16_t*)(ws + WS_SSMW); F.SIDE = (float*)(ws + WS_SIDE);
    for (int u = F.tid; u < (LDS_BYTES - LDSCTL_OFF) / 4; u += NTHREADS) ((LAS unsigned*)(F.lds + LDSCTL_OFF))[u] = 0u;
    __syncthreads();
    const int lo = args.ph_lo, hi = args.ph_hi;
    XcdBarrier bar; bar.bar = (unsigned*)(ws + WS_CTL) + CW_BAR; bar.x = 0; bar.st = nullptr;
    bar = xcd_barrier_post((unsigned*)(ws + WS_CTL) + CW_BAR, MISCL + 8);
#define IN(k) (lo <= (k) && (k) < hi)
#define SEAM(k) do { if (IN(k) && IN((k) + 1)) xcd_barrier(bar); } while (0)

#define PH0(rp) { p0_prologue(F, (rp) == 0 ? 15 : args.p3mask); }
#define PH1(rp) { p1_prep_x(F); }
#define PH2(rp) { pg8::Gemm g{F.XN, F.WIN, NTOK, DIN, DM}; pg8::StaticOrder S; S.init(NTOK, DIN, F.G, (int)blockIdx.x); \
        EpiIn E{F.Q, F.KALL, F.VALL, F.GA, F.U, F.GS, F.out, F.ROPE}; \
        pg8::gemm_phase<EpiIn, pg8::StaticOrder, true, true>(F.lds, g, S, E); }
#ifdef SSM_PROBE
#define YS_DST (bf16_t*)F.OUT
#else
#define YS_DST F.YS
#endif
#define PH3(rp) { const int pm = (rp) == 0 ? 7 : args.p3mask; \
        const float lam = __uint_as_float(__hip_atomic_load((unsigned*)F.MISC, RLX_AGENT)); \
        const int bx = blockIdx.x, vcu = (F.G % 8 == 0) ? (bx % 8) * (F.G / 8) + bx / 8 : bx;     \
        for (int u0 = vcu; u0 < 512; u0 += F.G) { \
            int u = u0; \
            if (u0 >= 256) {                                     \
                if (u0 < 256 + 192) { const int it = u0 - 256, g = it / 6, sub = it % 6; \
                    if (pm & 2) ssm::item(g, sub < 4 ? 1 : 0, sub < 4 ? 2 * sub : 8 * (sub - 4), F.U, F.SSMW + (size_t)g * ssm::W_ELEMS, F.SIDE + g * ssm::SIDE_F32, F.state_ssm, YS_DST, F.out, F.lds); \
                    continue; } \
                u = 256 + 2 * (u0 - 448); \
                if (!(pm & 4)) continue; \
            } else if (!(pm & 1)) continue; \
            for (int rep = 0; rep < (u0 >= 256 ? 2 : 1); ++rep, ++u) { \
            int tok0, kbase, seq, h; \
            if (u < 256) { const int bh = u >> 3, b = bh >> 2; h = bh & 3; tok0 = NTOK_I + b * 1024 + (u & 7) * 128; kbase = 4096 + b * 1280; seq = 1280; } \
            else { const int s = u - 256, bh = s >> 1, b = bh >> 2; h = bh & 3; tok0 = b * 256 + (s & 1) * 128; kbase = b * 256; seq = 256; } \
            if ((rp) && args.pad) seq = args.pad; \
            att::attn_unit(F.Q + (size_t)tok0 * 512 + h * 128, F.KALL + (size_t)kbase * 512 + h * 128, F.VALL + (size_t)kbase * 512 + h * 128, seq, (char*)lds_raw, lam, \
                           F.subln, F.GA + (size_t)tok0 * 512 + h * 128, F.CAT + (size_t)tok0 * 1024 + h * 128, (rp) && args.pad); \
            } \
        } }
#define PH4(rp) { pg8::Gemm g{F.YS, F.WGLU, NTOK, 512, 512}; pg8::StaticOrder S; S.init(NTOK, 512, F.G, (int)blockIdx.x); \
        EpiGlu E{F.YS, F.GS, F.b_glu, F.CAT}; \
        pg8::gemm_phase<EpiGlu, pg8::StaticOrder, true, true>(F.lds, g, S, E); }
#define PH5(rp) { pg8::Gemm g{F.CAT, F.WOUT, NTOK, DM, DM}; pg8::StaticOrder S; S.init(NTOK, DM, F.G, (int)blockIdx.x); \
        EpiOut E{F.OUT}; \
        pg8::gemm_phase<EpiOut, pg8::StaticOrder, true, true>(F.lds, g, S, E); }
#define PH6(rp) { p6_final(F); }
#ifdef DUP_PHASE
#define RUN(k, BODY) do { if (IN(k)) { BODY(0) if (DUP_PHASE == (k)) { xcd_barrier(bar); BODY(1) } } } while (0)
#else
#define RUN(k, BODY) do { if (IN(k)) { BODY(0) } } while (0)
#endif
    RUN(0, PH0); SEAM(0);
    RUN(1, PH1); SEAM(1);
    RUN(2, PH2); SEAM(2);
    RUN(3, PH3); SEAM(3);
    RUN(4, PH4); SEAM(4);
    RUN(5, PH5); SEAM(5);
    RUN(6, PH6);
#undef RUN
#undef IN
#undef SEAM
}
template <class Epi> __global__ void __launch_bounds__(256) k_gemm_naive(const bf16_t* A, const bf16_t* Bt, int M, int N, int K, Epi E) {
    __shared__ float As[16][65], Bs[16][65];
    const int tx = threadIdx.x & 15, ty = threadIdx.x >> 4, m0 = blockIdx.y * 64, n0 = blockIdx.x * 64;
    float acc[4][4];
#pragma unroll
    for (int i = 0; i < 4; ++i)
#pragma unroll
        for (int j = 0; j < 4; ++j) acc[i][j] = 0.f;
    for (int k0 = 0; k0 < K; k0 += 16) {
#pragma unroll
        for (int i = 0; i < 4; ++i) { const int e = threadIdx.x + 256 * i, r = e >> 4, kk = e & 15;
            As[kk][r] = bf2f(A[(size_t)(m0 + r) * K + k0 + kk]); Bs[kk][r] = bf2f(Bt[(size_t)(n0 + r) * K + k0 + kk]); }
        __syncthreads();
#pragma unroll
        for (int kk = 0; kk < 16; ++kk) { float a[4], b[4];
#pragma unroll
            for (int i = 0; i < 4; ++i) { a[i] = As[kk][ty + 16 * i]; b[i] = Bs[kk][tx + 16 * i]; }
#pragma unroll
            for (int i = 0; i < 4; ++i)
#pragma unroll
                for (int j = 0; j < 4; ++j) acc[i][j] += a[i] * b[j]; }
        __syncthreads();
    }
#pragma unroll
    for (int i = 0; i < 4; ++i) E(m0 + ty + 16 * i, n0, tx, acc[i]);
}
struct EpiInNaive {
    bf16_t *Q, *KALL, *VALL, *GA, *U, *GS; float* out; const float* ROPE;
    __device__ void operator()(int m, int n0, int tx, const float (&v)[4]) const {
        const int sec = n0 >> 9; float w[4] = {v[0], v[1], v[2], v[3]};
        if (sec < 2 && m >= NTOK_I) {
            const int t = (m - NTOK_I) & 1023, prow = t >> 6, pcol = t & 63;
            { const float c = ROPE[prow * 16 + tx], s = ROPE[1024 + prow * 16 + tx]; w[0] = v[0] * c - v[1] * s; w[1] = v[1] * c + v[0] * s; }
            { const float c = ROPE[pcol * 16 + tx], s = ROPE[1024 + pcol * 16 + tx]; w[2] = v[2] * c - v[3] * s; w[3] = v[3] * c + v[2] * s; }
        }
#pragma unroll
        for (int j = 0; j < 4; ++j) { const int cc = (n0 & 511) + tx + 16 * j; const float x = w[j];
            if (sec == 0) Q[(size_t)m * 512 + cc] = f2bf(x);
            else if (sec == 1) { KALL[(size_t)key_row(m) * 512 + cc] = f2bf(x); if (m < NTOK_I) out[O_NK + (size_t)m * 512 + cc] = x; }
            else if (sec == 2) { VALL[(size_t)key_row(m) * 512 + cc] = f2bf(x); if (m < NTOK_I) out[O_NV + (size_t)m * 512 + cc] = x; }
            else if (sec == 3) GA[(size_t)m * 512 + cc] = f2bf(siluf(x));
            else if (sec == 4) U[(size_t)m * 512 + cc] = f2bf(x);
            else GS[(size_t)m * 512 + cc] = f2bf(siluf(x)); }
    }
};
struct EpiGluNaive {
    const bf16_t *YS, *GS; const float* b_glu; bf16_t* CAT;
    __device__ void operator()(int m, int n0, int tx, const float (&v)[4]) const {
#pragma unroll
        for (int j = 0; j < 4; ++j) { const int n = n0 + tx + 16 * j; const float ys = bf2f(YS[(size_t)m * 512 + n]), gs = bf2f(GS[(size_t)m * 512 + n]);
            CAT[(size_t)m * 1024 + 512 + n] = f2bf(ys * sigmoidf(v[j] + b_glu[n]) * gs); }
    }
};
struct EpiOutNaive {
    float* OUT;
    __device__ void operator()(int m, int n0, int tx, const float (&v)[4]) const {
#pragma unroll
        for (int j = 0; j < 4; ++j) OUT[(size_t)m * 1024 + n0 + tx + 16 * j] = v[j];
    }
};

__global__ void __launch_bounds__(256) k_attn_naive(const bf16_t* Q, const bf16_t* KALL, const bf16_t* VALL, const bf16_t* GA, const float* subln, const float* MISC, bf16_t* CAT) {
    __shared__ float P[4][2][1280]; __shared__ float qs[4][128];
    const int h = threadIdx.x >> 6, lane = threadIdx.x & 63, m = blockIdx.x;
    const int kbase = m < NTOK_I ? (m >> 8) * 256 : 4096 + ((m - NTOK_I) >> 10) * 1280, nk = m < NTOK_I ? 256 : 1280;
    const float lam = MISC[0];
    qs[h][lane] = bf2f(Q[(size_t)m * 512 + h * 128 + lane]); qs[h][64 + lane] = bf2f(Q[(size_t)m * 512 + h * 128 + 64 + lane]);
    __syncthreads();
    float mx0 = -1e30f, mx1 = -1e30f;
    for (int kk = lane; kk < nk; kk += 64) { const bf16_t* kr = KALL + (size_t)(kbase + kk) * 512 + h * 128; float s0 = 0.f, s1 = 0.f;
        for (int d = 0; d < 64; ++d) { s0 += qs[h][d] * bf2f(kr[d]); s1 += qs[h][64 + d] * bf2f(kr[64 + d]); }
        s0 *= 0.125f; s1 *= 0.125f; P[h][0][kk] = s0; P[h][1][kk] = s1; mx0 = fmaxf(mx0, s0); mx1 = fmaxf(mx1, s1); }
    mx0 = wave_max(mx0); mx1 = wave_max(mx1);
    float l0 = 0.f, l1 = 0.f;
    for (int kk = lane; kk < nk; kk += 64) { const float p0 = expf(P[h][0][kk] - mx0), p1 = expf(P[h][1][kk] - mx1); P[h][0][kk] = p0; P[h][1][kk] = p1; l0 += p0; l1 += p1; }
    l0 = wave_sum(l0); l1 = wave_sum(l1);
    const float i0 = 1.f / l0, i1 = lam / l1;
    for (int kk = lane; kk < nk; kk += 64) P[h][0][kk] = P[h][0][kk] * i0 - P[h][1][kk] * i1;
    __syncthreads();
    float o0 = 0.f, o1 = 0.f;
    for (int kk = 0; kk < nk; ++kk) { const float w = P[h][0][kk]; const bf16_t* vr = VALL + (size_t)(kbase + kk) * 512 + h * 128; o0 += w * bf2f(vr[lane]); o1 += w * bf2f(vr[64 + lane]); }
    const float ss = wave_sum(o0 * o0 + o1 * o1), r = rsqrtf(ss * (1.f / 128.f) + EPS) * (1.f - LAM_INIT);
    const size_t gi = (size_t)m * 512 + h * 128;
    CAT[(size_t)m * 1024 + h * 128 + lane] = f2bf(o0 * r * subln[lane] * bf2f(GA[gi + lane]));
    CAT[(size_t)m * 1024 + h * 128 + 64 + lane] = f2bf(o1 * r * subln[64 + lane] * bf2f(GA[gi + 64 + lane]));
}

__global__ void __launch_bounds__(64) k_ssm_naive(const bf16_t* U, const float* A_re, const float* A_im, const float* log_dt, const float* B_re, const float* B_im,
                                                  const float* C_re, const float* C_im, const float* state_ssm, float* YF, float* YB, float* out) {
    const int ub = blockIdx.x >> 6, g = (blockIdx.x >> 1) & 31, d = blockIdx.x & 1, p = threadIdx.x;
    const int L = ub < 16 ? 256 : 1024; const size_t tok0 = ub < 16 ? (size_t)ub * 256 : 4096 + (size_t)(ub - 16) * 1024;
    const int dg = d * 32 + g;
    const float dt = expf(log_dt[dg]), Ar = A_re[dg * 64 + p], Ai = A_im[dg * 64 + p];
    const float mag = expf(Ar * dt), abr = mag * cosf(Ai * dt), abi = mag * sinf(Ai * dt);
    const float nr = abr - 1.f, ni = abi, den = Ar * Ar + Ai * Ai, fr = (nr * Ar + ni * Ai) / den, fi = (ni * Ar - nr * Ai) / den;
    float bbr[16], bbi[16], cr[16], ci[16];
#pragma unroll
    for (int h = 0; h < 16; ++h) { const float Br = B_re[(size_t)(dg * 64 + p) * 16 + h], Bi = B_im[(size_t)(dg * 64 + p) * 16 + h];
        bbr[h] = fr * Br - fi * Bi; bbi[h] = fr * Bi + fi * Br; cr[h] = C_re[(size_t)(dg * 16 + h) * 64 + p]; ci[h] = C_im[(size_t)(dg * 16 + h) * 64 + p]; }
    float hr = 0.f, hi = 0.f;
    if (ub >= 16) { const size_t sb = ((size_t)((ub - 16) * 2 + d) * 2) * 2048 + g * 64 + p; hr = state_ssm[sb]; hi = state_ssm[sb + 2048]; }
    float* Y = d == 0 ? YF : YB;
    for (int s = 0; s < L; ++s) { const int t = d == 0 ? s : L - 1 - s;
        const float uval = p < 16 ? bf2f(U[(tok0 + t) * 512 + g * 16 + p]) : 0.f;
        float bur = 0.f, bui = 0.f;
#pragma unroll
        for (int h = 0; h < 16; ++h) { const float uh = __shfl(uval, h); bur += bbr[h] * uh; bui += bbi[h] * uh; }
        const float nhr = abr * hr - abi * hi + bur, nhi = abr * hi + abi * hr + bui; hr = nhr; hi = nhi;
        float yout = 0.f;
#pragma unroll
        for (int hc = 0; hc < 16; ++hc) { const float v = wave_sum(cr[hc] * hr - ci[hc] * hi); if (p == hc) yout = v; }
        if (p < 16) Y[(tok0 + t) * 512 + g * 16 + p] = yout;
    }
    if (ub < 16) { const size_t sb = ((size_t)(ub * 2 + d) * 2) * 2048 + g * 64 + p; out[O_NS + sb] = hr; out[O_NS + sb + 2048] = hi; }
}
__global__ void __launch_bounds__(256) k_ys(const float* YF, const float* YB, const bf16_t* U, const float* Dskip, bf16_t* YS) {
    const size_t n = (size_t)NTOK * 512;
    for (size_t i = blockIdx.x * 256 + threadIdx.x; i < n; i += (size_t)gridDim.x * 256) YS[i] = f2bf(gelu_tanh(YF[i] + YB[i] + Dskip[i & 511] * bf2f(U[i])));
}
__global__ void __launch_bounds__(256) k_final(const float* xp, const float* xs, const float* OUT, const float* norm_post, const float* MOD, float* out) {
    const int gw = (blockIdx.x * 256 + threadIdx.x) >> 6, lane = threadIdx.x & 63, nw = (gridDim.x * 256) >> 6;
    for (int m = gw; m < NTOK; m += nw) {
        const float* xr = m < NTOK_I ? xp + (size_t)m * DM : xs + (size_t)(m - NTOK_I) * DM;
        const float* gate = MOD + mod_index(m) * DIN + 2 * DM; const float* orow = OUT + (size_t)m * DM;
        float4 v[4]; float ss = 0.f;
#pragma unroll
        for (int j = 0; j < 4; ++j) { v[j] = ((const float4*)orow)[lane + 64 * j]; ss += v[j].x * v[j].x + v[j].y * v[j].y + v[j].z * v[j].z + v[j].w * v[j].w; }
        ss = wave_sum(ss); const float r = rsqrtf(ss * (1.f / DM) + EPS);
#pragma unroll
        for (int j = 0; j < 4; ++j) { const int i4 = lane + 64 * j; const float4 g = ((const float4*)norm_post)[i4], ga = ((const float4*)gate)[i4], x = ((const float4*)xr)[i4];
            float4 o; o.x = x.x + ga.x * v[j].x * r * g.x; o.y = x.y + ga.y * v[j].y * r * g.y; o.z = x.z + ga.z * v[j].z * r * g.z; o.w = x.w + ga.w * v[j].w * r * g.w;
            ((float4*)(out + (size_t)m * DM))[i4] = o; }
    }
}


#ifdef SSM_PROBE
__global__ void __launch_bounds__(256) k_probe_cmp(const float* YO, const float* YF, const float* YB, float* acc) {
    float num = 0.f, den = 0.f; const size_t n = (size_t)NTOK * 512;
    for (size_t i = blockIdx.x * 256 + threadIdx.x; i < n; i += (size_t)gridDim.x * 256) { const float r = YF[i] + YB[i], d = YO[i] - r; num += d * d; den += r * r; }
    num = wave_sum(num); den = wave_sum(den);
    if ((threadIdx.x & 63) == 0) { atomicAdd(acc, num); atomicAdd(acc + 1, den); }
}
__global__ void __launch_bounds__(256) k_probe_poke(float* out, const float* acc) {
    const float f = 1.f + sqrtf(acc[0] / acc[1]);
    for (size_t i = blockIdx.x * 256 + threadIdx.x; i < 4194304; i += (size_t)gridDim.x * 256) out[i] *= f;
}
#endif
static void launch_mega(const Args& a0, int lo, int hi, int grid, hipStream_t stream) {
    Args a = a0; a.ph_lo = lo; a.ph_hi = hi;
    void* params[] = {&a};
    hipError_t e = hipLaunchCooperativeKernel((const void*)mega, dim3(grid), dim3(NTHREADS), params, LDS_BYTES, stream);
    if (e != hipSuccess) fprintf(stderr, "kernel_launch: cooperative launch [%d,%d) failed: %s (grid %d)\n", lo, hi, hipGetErrorString(e), grid);
}
extern "C" void kernel_launch(void* const* d_in, const int* in_sizes, int n_in, void* d_out, int out_size, void* d_ws, size_t ws_size, hipStream_t stream) {
    static int grid = 0;
    if (grid == 0) {
        if (n_in != 25 || ws_size < WS_END) { fprintf(stderr, "kernel_launch: unexpected n_in %d / ws %zu\n", n_in, ws_size); grid = -1; return; }
        int dev = 0, cus = 0, per_cu = 0;
        hipGetDevice(&dev); hipDeviceGetAttribute(&cus, hipDeviceAttributeMultiprocessorCount, dev);
        if (hipFuncSetAttribute((const void*)mega, hipFuncAttributeMaxDynamicSharedMemorySize, LDS_BYTES) != hipSuccess) { fprintf(stderr, "kernel_launch: hipFuncSetAttribute failed\n"); grid = -1; return; }
        hipOccupancyMaxActiveBlocksPerMultiprocessor(&per_cu, (const void*)mega, NTHREADS, LDS_BYTES);
        (void)hipGetLastError();
        if (per_cu < 1) fprintf(stderr, "kernel_launch: occupancy query reports %d blocks per CU\n", per_cu);
        grid = cus;
        if (grid != 256) { fprintf(stderr, "kernel_launch: built for a 256-CU device (work decomposition assumes a grid of 256), found %d CUs\n", cus); grid = -1; return; }
    }
    if (grid < 0) return;
    const float* x_prompt = (const float*)d_in[0]; const float* x_sample = (const float*)d_in[1];
    const float* state_ssm = (const float*)d_in[4];
    const float* norm_post = (const float*)d_in[10];
    const float* subln = (const float*)d_in[13]; const float* A_re = (const float*)d_in[14]; const float* A_im = (const float*)d_in[15];
    const float* log_dt = (const float*)d_in[16]; const float* B_re = (const float*)d_in[17]; const float* B_im = (const float*)d_in[18]; const float* C_re = (const float*)d_in[19];
    const float* C_im = (const float*)d_in[20]; const float* ssm_D = (const float*)d_in[21]; const float* b_glu = (const float*)d_in[23];
    float* out = (float*)d_out; char* ws = (char*)d_ws;
    float* MOD = (float*)(ws + WS_MOD); float* MISC = (float*)(ws + WS_MISC);
    bf16_t* WGLU = (bf16_t*)(ws + WS_WGLU); bf16_t* WOUT = (bf16_t*)(ws + WS_WOUT);
    bf16_t* Q = (bf16_t*)(ws + WS_Q); bf16_t* KALL = (bf16_t*)(ws + WS_K); bf16_t* VALL = (bf16_t*)(ws + WS_V);
    bf16_t* GA = (bf16_t*)(ws + WS_GA); bf16_t* U = (bf16_t*)(ws + WS_U); bf16_t* GS = (bf16_t*)(ws + WS_GS); bf16_t* YS = (bf16_t*)(ws + WS_YS);
    bf16_t* CAT = (bf16_t*)(ws + WS_CAT); float* OUT = (float*)(ws + WS_OUT); float* YF = (float*)(ws + WS_YF); float* YB = (float*)(ws + WS_YB);

    hipMemsetAsync(ws + WS_CTL, 0, CTL_ZERO_BYTES, stream);
    Args a{};
    for (int i = 0; i < 25; ++i) a.in[i] = (const float*)d_in[i];
    a.out = out; a.ws = (unsigned char*)d_ws;
    for (int k = 0; k < 8; ++k) a.rep[k] = 1;
    a.p3mask = 7;
#ifdef DUP_PHASE
#ifdef DUP_SEQ
    a.pad = DUP_SEQ;
#endif
#ifdef DUP_P3MASK
    a.p3mask = DUP_P3MASK;
#endif
#endif
#ifndef SSM_PROBE
    launch_mega(a, 0, 7, grid, stream);
#else
    launch_mega(a, 0, 2, grid, stream);
    launch_mega(a, 2, 3, grid, stream);
    launch_mega(a, 3, 4, grid, stream);
#ifdef SSM_PROBE
    k_ssm_naive<<<24 * 64, 64, 0, stream>>>(U, A_re, A_im, log_dt, B_re, B_im, C_re, C_im, state_ssm, YF, YB, out);
    k_ys<<<2048, 256, 0, stream>>>(YF, YB, U, ssm_D, YS);
    k_probe_cmp<<<1024, 256, 0, stream>>>(OUT, YF, YB, (float*)(ws + WS_CTL) + 60000);
#endif
    launch_mega(a, 4, 5, grid, stream);
    launch_mega(a, 5, 6, grid, stream);
    launch_mega(a, 6, 7, grid, stream);
    k_probe_poke<<<4096, 256, 0, stream>>>(out, (float*)(ws + WS_CTL) + 60000);
#endif
#ifdef SSM_PROBE_NEVER
    k_probe_poke<<<4096, 256, 0, stream>>>(out, (float*)(ws + WS_CTL) + 60000);
#endif
}
```

```cpp
#include <hip/hip_runtime.h>
#include <cstdint>
#include <cstdio>
#include <cmath>

typedef unsigned short bf16_t;
#define GAS __attribute__((address_space(1)))
#define LAS __attribute__((address_space(3)))
typedef unsigned v4u __attribute__((ext_vector_type(4)));
typedef unsigned v2u __attribute__((ext_vector_type(2)));
typedef float f32x4 __attribute__((ext_vector_type(4)));
typedef short bf16x8 __attribute__((ext_vector_type(8)));
typedef GAS unsigned gu32;
typedef GAS unsigned long long gu64;
#define RLX_AGENT __ATOMIC_RELAXED, __HIP_MEMORY_SCOPE_AGENT
#define LDS_WAIT() asm volatile("s_waitcnt lgkmcnt(0)" ::: "memory")
#define VM_WAIT() asm volatile("s_waitcnt vmcnt(0)" ::: "memory")
__device__ __forceinline__ unsigned f2bf(float f) { unsigned u = __builtin_bit_cast(unsigned, f); return (u + 0x7fffu + ((u >> 16) & 1u)) >> 16; }
__device__ __forceinline__ unsigned pk2(float lo, float hi) { return f2bf(lo) | (f2bf(hi) << 16); }
__device__ __forceinline__ float bf2f(bf16_t h) { return __uint_as_float(((unsigned)h) << 16); }
__device__ __forceinline__ float bflo(unsigned w) { return __uint_as_float(w << 16); }
__device__ __forceinline__ float bfhi(unsigned w) { return __uint_as_float(w & 0xffff0000u); }
__device__ __forceinline__ float wave_sum(float v) {
#pragma unroll
    for (int o = 1; o < 64; o <<= 1) v += __shfl_xor(v, o);
    return v;
}
__device__ __forceinline__ float wave_max(float v) {
#pragma unroll
    for (int o = 1; o < 64; o <<= 1) v = fmaxf(v, __shfl_xor(v, o));
    return v;
}
__device__ __forceinline__ float siluf(float x) { return x / (1.f + expf(-x)); }
__device__ __forceinline__ float sigmoidf(float x) { return 1.f / (1.f + expf(-x)); }
__device__ __forceinline__ float fast_sigmoid(float x) { return __builtin_amdgcn_rcpf(1.f + __builtin_amdgcn_exp2f(-1.4426950408889634f * x)); }
__device__ __forceinline__ float fast_silu(float x) { return x * fast_sigmoid(x); }
__device__ __forceinline__ float gelu_tanh(float x) { const float c = 0.7978845608028654f; return 0.5f * x * (1.f + tanhf(c * (x + 0.044715f * x * x * x))); }
__device__ __forceinline__ float fast_gelu_tanh(float x) { const float c2 = 1.5957691216057308f; return x * fast_sigmoid(c2 * (x + 0.044715f * x * x * x)); }

constexpr int DM = 1024, NTOK_I = 4096, NTOK = 12288, DIN = 3072;
constexpr int NKROWS = 4096 + 8 * 1280;
constexpr float EPS = 1e-6f, LAM_INIT = 0.2f;
constexpr size_t O_YP = 0, O_YS = 4194304, O_NK = 12582912, O_NV = 14680064, O_NS = 16777216;

constexpr size_t MiB = 1u << 20;
constexpr size_t WS_CTL = 0, CTL_ZERO_BYTES = 256 * 1024;
constexpr size_t WS_MOD = 1 * MiB + 128 * 1024;
constexpr size_t WS_MISC = 1 * MiB;
constexpr size_t WS_ROPE = WS_MISC + 1024;
constexpr size_t WS_WIN = 2 * MiB;
constexpr size_t WS_WGLU = 8 * MiB;
constexpr size_t WS_WOUT = 9 * MiB;
constexpr size_t WS_XN = 12 * MiB;
constexpr size_t WS_Q = 36 * MiB;
constexpr size_t WS_K = 48 * MiB;
constexpr size_t WS_V = 62 * MiB;
constexpr size_t WS_GA = 76 * MiB;
constexpr size_t WS_U = 88 * MiB;
constexpr size_t WS_GS = 100 * MiB;
constexpr size_t WS_YS = 112 * MiB;
constexpr size_t WS_CAT = 124 * MiB;
constexpr size_t WS_OUT = 148 * MiB;
constexpr size_t WS_YF = 196 * MiB;
constexpr size_t WS_YB = 220 * MiB;
constexpr size_t WS_SSMW = 244 * MiB;
constexpr size_t WS_SIDE = 1 * MiB + 64 * 1024;
constexpr size_t WS_END = 256 * MiB;
static_assert(WS_ROPE + 8192 <= WS_SIDE && WS_SIDE + 65536 <= WS_MOD && WS_MOD + 8 * 9 * 3072 * 4 <= WS_WIN, "small-table map");

__device__ __forceinline__ int mod_index(int m) { return m < NTOK_I ? 0 : 1 + ((m - NTOK_I) >> 10); }
__device__ __forceinline__ int key_row(int m) { return m < NTOK_I ? m : 4096 + ((m - NTOK_I) >> 10) * 1280 + 256 + ((m - NTOK_I) & 1023); }
namespace pg8 {
#define PG8_LAS __attribute__((address_space(3)))
typedef unsigned short bf16_t;
typedef short bf16x8 __attribute__((ext_vector_type(8)));
typedef float f32x4 __attribute__((ext_vector_type(4)));
typedef unsigned u32x4 __attribute__((ext_vector_type(4)));
constexpr int BM = 256, BK = 64, HALF = 128, HTB = HALF * BK * 2  , STAGE_BYTES = 8 * HTB, NXCD = 8, WGM = 8;

__host__ __device__ __forceinline__ int lds_byte(int r, int c) { const int st = (r >> 4) * 2 + (c >> 5), rr = r & 15, cc = c & 31, ob = rr * 64 + cc * 2; return st * 1024 + (ob ^ (((ob >> 9) & 1) << 5)); }
__host__ __device__ __forceinline__ void stage_rc(int b, int& R, int& C) { const int st = b / 1024, sb = b % 1024, swz = sb ^ (((sb >> 9) & 1) << 5); R = (st >> 1) * 16 + swz / 64; C = (st & 1) * 32 + (swz % 64) / 2; }
__host__ __device__ __forceinline__ int perm32(int rho) { const int n = rho >> 4, i = rho & 15; return 8 * (i >> 2) + 4 * n + (i & 3); }

struct Unit { int pm, pn; };
struct Gemm { const bf16_t* A; const bf16_t* Bt; int M, N, K; };

struct StaticOrder {
    int nM, nN, nwg, G, c;
    __host__ __device__ void init(int M, int N, int G_, int c_) { nM = M / BM; nN = N / BM; nwg = nM * nN; G = G_; c = c_; }
    __host__ __device__ bool next(int i, Unit& u) const {
        const long L = (long)i * G + c; if (L >= nwg) return false;
        int wgid = (int)L; { const int q = nwg / NXCD, r = nwg % NXCD, xcd = wgid % NXCD, off = wgid / NXCD; wgid = (xcd < r ? xcd * (q + 1) : r * (q + 1) + (xcd - r) * q) + off; }
        const int nig = WGM * nN, gid = wgid / nig, fm = gid * WGM, gsz = (nM - fm) < WGM ? (nM - fm) : WGM;
        u.pm = fm + ((wgid % nig) % gsz); u.pn = (wgid % nig) / gsz; return true;
    }
    __device__ __forceinline__ void a_ready(const Unit&) const {}
    __device__ __forceinline__ void done(const Unit&) const {}
};

__device__ __forceinline__ unsigned cvt_pk_bf16(float lo, float hi) { unsigned r; asm volatile("v_cvt_pk_bf16_f32 %0, %1, %2" : "=v"(r) : "v"(lo), "v"(hi)); return r; }
typedef float f32x2 __attribute__((ext_vector_type(2)));
template <class Epi, class Sched, bool ALIGN_EPI = false, bool SP2 = false>
__device__ __forceinline__ void gemm_phase(PG8_LAS unsigned char* lds, const Gemm g, const Sched& S, const Epi& E) {
    int tid_ = threadIdx.x; asm volatile("" : "+v"(tid_));
    const int tid = tid_, wid = __builtin_amdgcn_readfirstlane(tid >> 6), lane = tid & 63, wr = wid >> 2, wc = wid & 3, fr = lane & 15, fq = lane >> 4;
    const int K = g.K, nt = K / BK;
    unsigned voffA[2], voffB[2];
#pragma unroll
    for (int i = 0; i < 2; ++i) { int R, C; stage_rc(tid * 16 + i * 8192, R, C); const int Rb = Epi::PERM ? ((R & ~31) + perm32(R & 31)) : R;
        voffA[i] = (unsigned)(R * K + C) * 2u; voffB[i] = (unsigned)(Rb * K + C) * 2u; }
    const size_t kstep = (size_t)(BK * 2);
    const size_t hstep = (size_t)HALF * K * 2;
    const size_t tstep = 2 * hstep;
    const unsigned ldsw = (unsigned)wid * 1024u;
    const int aoff = lds_byte(wr * 64 + fr, fq * 8), boff = lds_byte(wc * 32 + fr, fq * 8);
#define PG8_SA(b, h) (((b) * 2 + (h)) * HTB)
#define PG8_SB(b, h) ((4 + (b) * 2 + (h)) * HTB)
#define PG8_STAGE(bufoff, gbase, voff) do { _Pragma("unroll") for (int _i = 0; _i < 2; ++_i) \
        __builtin_amdgcn_global_load_lds((const unsigned*)((const char*)(gbase) + (voff)[_i]), (PG8_LAS unsigned*)(lds + (bufoff) + ldsw + _i * 8192), 16, 0, 0); } while (0)
#define PG8_LDA(dst, b, h) do { _Pragma("unroll") for (int m = 0; m < 4; ++m) _Pragma("unroll") for (int k = 0; k < 2; ++k) dst[m][k] = *(const PG8_LAS bf16x8*)(lds + PG8_SA(b, h) + aoff + m * 2048 + k * 1024); } while (0)
#define PG8_LDB(dst, b, h) do { _Pragma("unroll") for (int n = 0; n < 2; ++n) _Pragma("unroll") for (int k = 0; k < 2; ++k) dst[n][k] = *(const PG8_LAS bf16x8*)(lds + PG8_SB(b, h) + boff + n * 2048 + k * 1024); } while (0)
#define PG8_MMA(ai, bj, At, Bt) do { __builtin_amdgcn_s_setprio(1); _Pragma("unroll") for (int m = 0; m < 4; ++m) _Pragma("unroll") for (int n = 0; n < 2; ++n) _Pragma("unroll") for (int k = 0; k < 2; ++k) \
        acc[ai][bj][m][n] = __builtin_amdgcn_mfma_f32_16x16x32_bf16(Bt[n][k], At[m][k], acc[ai][bj][m][n], 0, 0, 0); __builtin_amdgcn_s_setprio(0); } while (0)
#define PG8_WAIT_V(n) asm volatile("s_waitcnt vmcnt(" #n ")" ::: "memory")
#define PG8_WAIT_L(n) asm volatile("s_waitcnt lgkmcnt(" #n ")" ::: "memory")
#define PG8_BAR __builtin_amdgcn_s_barrier()
#define PG8_SCHED __builtin_amdgcn_sched_barrier(0)
    Unit cur, nxt; int ui = 0;
    if (!S.next(0, cur)) return;
    f32x4 acc[2][2][4][2];
#pragma unroll
    for (int a = 0; a < 2; ++a)
#pragma unroll
        for (int b = 0; b < 2; ++b)
#pragma unroll
            for (int m = 0; m < 4; ++m)
#pragma unroll
                for (int n = 0; n < 2; ++n) acc[a][b][m][n] = (f32x4){0.f, 0.f, 0.f, 0.f};
    bf16x8 At[4][2], B0[2][2], B1[2][2];
    const char* cA = (const char*)g.A + (size_t)cur.pm * tstep; const char* cB = (const char*)g.Bt + (size_t)cur.pn * tstep;
    S.a_ready(cur);
    if constexpr (SP2) {
        PG8_STAGE(PG8_SB(0, 0), cB, voffB); PG8_STAGE(PG8_SB(0, 1), cB + hstep, voffB); PG8_STAGE(PG8_SA(0, 0), cA, voffA); PG8_STAGE(PG8_SA(0, 1), cA + hstep, voffA);
        if (wr == 1) PG8_BAR;
        PG8_WAIT_V(2); PG8_BAR;
        PG8_STAGE(PG8_SB(1, 0), cB + kstep, voffB); PG8_STAGE(PG8_SA(1, 0), cA + kstep, voffA); PG8_STAGE(PG8_SB(1, 1), cB + hstep + kstep, voffB);
        PG8_WAIT_V(6); PG8_BAR;
    } else {
        PG8_STAGE(PG8_SB(0, 0), cB, voffB); PG8_STAGE(PG8_SA(0, 0), cA, voffA); PG8_STAGE(PG8_SB(0, 1), cB + hstep, voffB); PG8_STAGE(PG8_SA(0, 1), cA + hstep, voffA);
        if (wr == 1) PG8_BAR;
        PG8_WAIT_V(4); PG8_BAR;
        PG8_STAGE(PG8_SB(1, 0), cB + kstep, voffB); PG8_STAGE(PG8_SA(1, 0), cA + kstep, voffA); PG8_STAGE(PG8_SB(1, 1), cB + hstep + kstep, voffB);
        PG8_WAIT_V(6); PG8_BAR;
    }
    for (;;) {
        const bool has_next = S.next(ui + 1, nxt);
        const char* nA = has_next ? (const char*)g.A + (size_t)nxt.pm * tstep : cA; const char* nB = has_next ? (const char*)g.Bt + (size_t)nxt.pn * tstep : cB;
        for (int t = 0; t < nt; t += 2) {
            const bool last = (t == nt - 2);
            const char* a1 = cA + (size_t)(t + 1) * kstep;
            const char* a2 = last ? nA : cA + (size_t)(t + 2) * kstep; const char* b2 = last ? nB : cB + (size_t)(t + 2) * kstep;
            const char* a3 = a2 + kstep; const char* b3 = b2 + kstep;
            if (last && has_next) S.a_ready(nxt);
            if constexpr (SP2) {
            PG8_LDB(B0, 0, 0); PG8_LDB(B1, 0, 1); PG8_SCHED; PG8_LDA(At, 0, 0); PG8_STAGE(PG8_SA(1, 1), a1 + hstep, voffA);
            PG8_WAIT_V(8); PG8_WAIT_L(0); PG8_BAR; PG8_MMA(0, 0, At, B0); PG8_MMA(0, 1, At, B1); PG8_BAR; PG8_SCHED;
            PG8_LDA(At, 0, 1); PG8_STAGE(PG8_SB(0, 0), b2, voffB); PG8_STAGE(PG8_SB(0, 1), b2 + hstep, voffB); PG8_STAGE(PG8_SA(0, 0), a2, voffA);
            PG8_WAIT_V(8); PG8_WAIT_L(0); PG8_BAR; PG8_MMA(1, 0, At, B0); PG8_MMA(1, 1, At, B1); PG8_BAR; PG8_SCHED;
            PG8_LDB(B0, 1, 0); PG8_LDB(B1, 1, 1); PG8_SCHED; PG8_LDA(At, 1, 0); PG8_STAGE(PG8_SA(0, 1), a2 + hstep, voffA);
            PG8_WAIT_V(8); PG8_WAIT_L(0); PG8_BAR; PG8_MMA(0, 0, At, B0); PG8_MMA(0, 1, At, B1); PG8_BAR; PG8_SCHED;
            PG8_LDA(At, 1, 1); PG8_STAGE(PG8_SB(1, 0), b3, voffB); PG8_STAGE(PG8_SB(1, 1), b3 + hstep, voffB); PG8_STAGE(PG8_SA(1, 0), a3, voffA);
            PG8_WAIT_V(8); PG8_WAIT_L(0); PG8_BAR; PG8_MMA(1, 0, At, B0); PG8_MMA(1, 1, At, B1); PG8_BAR; PG8_SCHED;
            } else {
            PG8_LDB(B0, 0, 0); PG8_SCHED; PG8_LDA(At, 0, 0); PG8_STAGE(PG8_SA(1, 1), a1 + hstep, voffA);
            PG8_WAIT_L(8); PG8_BAR; PG8_WAIT_L(0); PG8_MMA(0, 0, At, B0); PG8_BAR; PG8_SCHED;
            PG8_LDB(B1, 0, 1); PG8_STAGE(PG8_SB(0, 0), b2, voffB);
            PG8_BAR; PG8_WAIT_L(0); PG8_MMA(0, 1, At, B1); PG8_BAR;
            PG8_LDA(At, 0, 1); PG8_STAGE(PG8_SA(0, 0), a2, voffA);
            PG8_BAR; PG8_WAIT_L(0); PG8_MMA(1, 0, At, B0); PG8_BAR; PG8_SCHED;
            PG8_STAGE(PG8_SB(0, 1), b2 + hstep, voffB);
            PG8_WAIT_V(6); PG8_BAR; PG8_MMA(1, 1, At, B1); PG8_BAR;
            PG8_LDB(B0, 1, 0); PG8_SCHED; PG8_LDA(At, 1, 0); PG8_STAGE(PG8_SA(0, 1), a2 + hstep, voffA);
            PG8_WAIT_L(8); PG8_BAR; PG8_WAIT_L(0); PG8_MMA(0, 0, At, B0); PG8_BAR; PG8_SCHED;
            PG8_LDB(B1, 1, 1); PG8_STAGE(PG8_SB(1, 0), b3, voffB);
            PG8_BAR; PG8_WAIT_L(0); PG8_MMA(0, 1, At, B1); PG8_BAR;
            PG8_LDA(At, 1, 1); PG8_STAGE(PG8_SA(1, 0), a3, voffA);
            PG8_BAR; PG8_WAIT_L(0); PG8_MMA(1, 0, At, B0); PG8_BAR; PG8_SCHED;
            PG8_STAGE(PG8_SB(1, 1), b3 + hstep, voffB);
            PG8_WAIT_V(6); PG8_BAR; PG8_MMA(1, 1, At, B1); PG8_BAR;
            }
        }
        if constexpr (ALIGN_EPI) { if (wr == 0) PG8_BAR; }
        if constexpr (!Epi::AFTER_DRAIN) { E(acc, cur, wr, wc, fr, fq); S.done(cur); }
        if (!has_next) break;
#pragma unroll
        for (int a = 0; a < 2; ++a)
#pragma unroll
            for (int b = 0; b < 2; ++b)
#pragma unroll
                for (int m = 0; m < 4; ++m)
#pragma unroll
                    for (int n = 0; n < 2; ++n) acc[a][b][m][n] = (f32x4){0.f, 0.f, 0.f, 0.f};
        cur = nxt; cA = nA; cB = nB; ++ui;
        if constexpr (ALIGN_EPI) { if (wr == 1) PG8_BAR; }
    }
    PG8_WAIT_V(0);
    if constexpr (!ALIGN_EPI) { if (wr == 0) PG8_BAR; }
    PG8_BAR;
    if constexpr (Epi::AFTER_DRAIN) { E.fused(acc, cur, wr, wc, fr, fq, lds, wid, lane); S.done(cur); }
#undef PG8_SA
#undef PG8_SB
#undef PG8_STAGE
#undef PG8_LDA
#undef PG8_LDB
#undef PG8_MMA
#undef PG8_WAIT_V
#undef PG8_WAIT_L
#undef PG8_BAR
#undef PG8_SCHED
}
}
#define XB_TMO      128
#define XB_XCNT(j)  (256  + 64 * (j))
#define XB_XSUB(j)  (1280 + 64 * (j))
#define XB_XGEN(j)  (2304 + 64 * (j))
#define XB_TOP      3328
#define XB_TOPGEN   3392
#define XCD_BAR_WORDS 3456
#define XB_SPIN_CAP (1u << 18)

__device__ __forceinline__ unsigned xb_ld(unsigned* p)              { return __hip_atomic_load(p, __ATOMIC_RELAXED, __HIP_MEMORY_SCOPE_AGENT); }
__device__ __forceinline__ unsigned xb_add(unsigned* p, unsigned v) { return __hip_atomic_fetch_add(p, v, __ATOMIC_RELAXED, __HIP_MEMORY_SCOPE_AGENT); }
__device__ __forceinline__ unsigned xb_xcc_id() { return (unsigned)__builtin_amdgcn_s_getreg((3 << 11) | 20) & 0xFu; }
#define XB_SPIN(cond, bar) do { unsigned _sp = 0; while (cond) { __builtin_amdgcn_s_sleep(1); \
    if ((++_sp & 255u) == 0u) { if (xb_ld(&(bar)[XB_TMO])) break; if (_sp > XB_SPIN_CAP) { atomicAdd(&(bar)[XB_TMO], 1u); break; } } } } while (0)

struct XcdBarrier {
    unsigned* bar; unsigned x;
    volatile LAS unsigned* st;
};

__device__ __forceinline__ XcdBarrier xcd_barrier_post(unsigned* bar, volatile LAS unsigned* st) {
    XcdBarrier b; b.bar = bar; b.x = xb_xcc_id(); b.st = st;
    if (threadIdx.x == 0) (void)xb_add(&bar[XB_XCNT(b.x)], 1u);
    return b;
}
__device__ __forceinline__ void xcd_barrier_complete(unsigned* bar, unsigned x, unsigned& nloc, unsigned& nx) {
    const unsigned G = gridDim.x * gridDim.y * gridDim.z;
    unsigned sum, cnt, mine, sp = 0u;
    for (;;) {
        sum = 0u; cnt = 0u; mine = 0u;
#pragma unroll
        for (unsigned j = 0; j < 16; ++j) { const unsigned c = xb_ld(&bar[XB_XCNT(j)]); sum += c; cnt += (c > 0u) ? 1u : 0u; mine = (j == x) ? c : mine; }
        if (sum == G) break;
        __builtin_amdgcn_s_sleep(1);
        if ((++sp & 255u) == 0u) { if (xb_ld(&bar[XB_TMO])) break; if (sp > XB_SPIN_CAP) { atomicAdd(&bar[XB_TMO], 1u); break; } }
    }
    nloc = mine > 0u ? mine : 1u; nx = cnt > 0u ? cnt : 1u;
}

__device__ __forceinline__ void xcd_barrier(const XcdBarrier& b) {
    asm volatile("s_waitcnt vmcnt(0)" ::: "memory");
    __syncthreads();
    if (threadIdx.x == 0) {
        unsigned* bar = b.bar;
        __builtin_amdgcn_s_waitcnt(0);
        unsigned nloc = b.st[0], nx = b.st[1];
        if (nloc == 0u) { xcd_barrier_complete(bar, b.x, nloc, nx); b.st[0] = nloc; b.st[1] = nx; }
        const unsigned old = xb_add(&bar[XB_XSUB(b.x)], 1u);
        const unsigned gen = old / nloc;
        if (old + 1u == (gen + 1u) * nloc) {
            __builtin_amdgcn_fence(__ATOMIC_RELEASE, "agent");
            asm volatile("s_waitcnt vmcnt(0)" ::: "memory");
            const unsigned og = xb_add(&bar[XB_TOP], 1u);
            const unsigned tg = og / nx;
            if (og + 1u == (tg + 1u) * nx) xb_add(&bar[XB_TOPGEN], 1u);
            else XB_SPIN(xb_ld(&bar[XB_TOPGEN]) == tg, bar);
            __builtin_amdgcn_fence(__ATOMIC_ACQUIRE, "agent");
            xb_add(&bar[XB_XGEN(b.x)], 1u);
            asm volatile("s_waitcnt vmcnt(0)" ::: "memory");
        } else {
            XB_SPIN(xb_ld(&bar[XB_XGEN(b.x)]) == gen, bar);
            __builtin_amdgcn_fence(__ATOMIC_ACQUIRE, "agent");
            asm volatile("s_waitcnt vmcnt(0)" ::: "memory");
        }
    }
    __syncthreads();
}

namespace att {
using s16x4  = __attribute__((ext_vector_type(4))) short;
using f32x16 = __attribute__((ext_vector_type(16))) float;
using u32x4  = __attribute__((ext_vector_type(4))) unsigned;
constexpr int QBLK = 32, KVBLK = 64, LDK = 512, LDQ = 512;
constexpr float SCALE = 0.125f, THR = 8.f;
constexpr size_t SHM_V = KVBLK * 128 * 2, SHM_K = KVBLK * 128 * 2, SHM_ATTN = 2 * SHM_V + 2 * SHM_K + 8 * 64 * 4;
#define KSWZ(row, colB) ((row) * 256 + ((colB) ^ (((row) & 7) << 4)))
#define SBAR() __builtin_amdgcn_sched_barrier(0)
__device__ __forceinline__ int crow(int r, int hi) { return (r & 3) + 8 * (r >> 2) + 4 * hi; }
__device__ __forceinline__ unsigned cvtpk(float lo, float hi) { unsigned r; asm volatile("v_cvt_pk_bf16_f32 %0, %1, %2" : "=v"(r) : "v"(lo), "v"(hi)); return r; }
__device__ __forceinline__ bf16x8 ld8(const bf16_t* p) { return *reinterpret_cast<const bf16x8*>(p); }

__device__ __forceinline__ void partialSM(f32x16& p0, f32x16& p1, float& m_reg, float& mn, float& alpha) {
  constexpr float C = SCALE * 1.4426950408889634f;
  float pmax = p0[0]; for (int r = 1; r < 16; ++r) pmax = fmaxf(pmax, p0[r]); for (int r = 0; r < 16; ++r) pmax = fmaxf(pmax, p1[r]);
  { auto rr = __builtin_amdgcn_permlane32_swap(__float_as_uint(pmax), __float_as_uint(pmax), false, false);
    pmax = fmaxf(__uint_as_float(rr[0]), __uint_as_float(rr[1])); }
  if (__builtin_expect(__all(pmax - m_reg <= THR / SCALE), 1)) { mn = m_reg; alpha = 1.f; }
  else { mn = fmaxf(m_reg, pmax); alpha = __builtin_amdgcn_exp2f((m_reg - mn) * C); m_reg = mn; }
  float mnC = -mn * C;
  for (int r = 0; r < 16; ++r) p0[r] = fmaf(p0[r], C, mnC); for (int r = 0; r < 16; ++r) p1[r] = fmaf(p1[r], C, mnC);
  for (int r = 0; r < 16; ++r) p0[r] = __builtin_amdgcn_exp2f(p0[r]);
}
__device__ __forceinline__ void finishSM(f32x16& p0, f32x16& p1, float alpha, float& l_reg, bf16x8& pa0, bf16x8& pa1, bf16x8& pa2, bf16x8& pa3) {
  for (int r = 0; r < 16; ++r) p1[r] = __builtin_amdgcn_exp2f(p1[r]);
  float ps = 0; for (int r = 0; r < 16; ++r) ps += p0[r]; for (int r = 0; r < 16; ++r) ps += p1[r];
  { auto rr = __builtin_amdgcn_permlane32_swap(__float_as_uint(ps), __float_as_uint(ps), false, false);
    ps = __uint_as_float(rr[0]) + __uint_as_float(rr[1]); }
  l_reg = l_reg * alpha + ps;
#define PK4(P, BASE, OUT) do { unsigned a0 = cvtpk(P[BASE + 0], P[BASE + 1]), a1 = cvtpk(P[BASE + 2], P[BASE + 3]);   \
    unsigned b0 = cvtpk(P[BASE + 4], P[BASE + 5]), b1 = cvtpk(P[BASE + 6], P[BASE + 7]);                              \
    auto r0 = __builtin_amdgcn_permlane32_swap(a0, b0, false, false); auto r1 = __builtin_amdgcn_permlane32_swap(a1, b1, false, false); \
    u32x4 w = {r0[0], r1[0], r0[1], r1[1]}; OUT = *reinterpret_cast<bf16x8*>(&w); } while (0)
  PK4(p0, 0, pa0); PK4(p0, 8, pa1); PK4(p1, 0, pa2); PK4(p1, 8, pa3);
#undef PK4
}
__device__ __forceinline__ void qkt(f32x16& p0, f32x16& p1, const bf16_t* Ks, const bf16x8* qr, int r32, int hi, int c) {
  p0 = f32x16{}; p1 = f32x16{};
#pragma unroll
  for (int d0 = 0; d0 < 4; ++d0) { int cb = (c * 64 + d0 * 16 + hi * 8) * 2;
    bf16x8 b0 = *reinterpret_cast<const bf16x8*>((const char*)Ks + KSWZ(r32, cb));
    bf16x8 b1 = *reinterpret_cast<const bf16x8*>((const char*)Ks + KSWZ(32 + r32, cb));
    p0 = __builtin_amdgcn_mfma_f32_32x32x16_bf16(b0, qr[d0], p0, 0, 0, 0);
    p1 = __builtin_amdgcn_mfma_f32_32x32x16_bf16(b1, qr[d0], p1, 0, 0, 0); }
}
__device__ __forceinline__ int v_st(int k, int c) { const int kk = (k & ~0xC) | ((k & 4) << 1) | ((k & 8) >> 1); return ((kk >> 3) * 4 + (c >> 5)) * 512 + ((kk & 7) * 32 + (c & 31)) * 2; }
__device__ __forceinline__ int v_rd_base(int lane) { return ((lane & 3) << 3) | (((lane >> 2) & 3) << 6) | (((lane >> 4) & 1) << 5) | (((lane >> 5) & 1) << 8); }
constexpr int v_rd_off(int d0, int ks, int half) { return d0 * 512 + ks * 4096 + half * 2048; }
template <int OFF> __device__ __forceinline__ s16x4 tr_read(int vb) {
  s16x4 r; asm volatile("ds_read_b64_tr_b16 %0, %1 offset:%2" : "=&v"(r) : "v"(vb), "i"(OFF) : "memory"); return r;
}
template <int D0> __device__ __forceinline__ void pv_one(f32x16& od, int vb, bf16x8 pa0, bf16x8 pa1, bf16x8 pa2, bf16x8 pa3) {
  const s16x4 l0 = tr_read<v_rd_off(D0, 0, 0)>(vb), h0 = tr_read<v_rd_off(D0, 0, 1)>(vb), l1 = tr_read<v_rd_off(D0, 1, 0)>(vb), h1 = tr_read<v_rd_off(D0, 1, 1)>(vb);
  const s16x4 l2 = tr_read<v_rd_off(D0, 2, 0)>(vb), h2 = tr_read<v_rd_off(D0, 2, 1)>(vb), l3 = tr_read<v_rd_off(D0, 3, 0)>(vb), h3 = tr_read<v_rd_off(D0, 3, 1)>(vb);
  asm volatile("s_waitcnt lgkmcnt(0)" ::: "memory"); SBAR();
#define PK(L, H) (bf16x8){L[0], L[1], L[2], L[3], H[0], H[1], H[2], H[3]}
  od = __builtin_amdgcn_mfma_f32_32x32x16_bf16(pa0, PK(l0, h0), od, 0, 0, 0);
  od = __builtin_amdgcn_mfma_f32_32x32x16_bf16(pa1, PK(l1, h1), od, 0, 0, 0);
  od = __builtin_amdgcn_mfma_f32_32x32x16_bf16(pa2, PK(l2, h2), od, 0, 0, 0);
  od = __builtin_amdgcn_mfma_f32_32x32x16_bf16(pa3, PK(l3, h3), od, 0, 0, 0);
#undef PK
}
__device__ __forceinline__ void pv_d0(f32x16* o, int vb, bf16x8 pa0, bf16x8 pa1, bf16x8 pa2, bf16x8 pa3) {
  pv_one<0>(o[0], vb, pa0, pa1, pa2, pa3); pv_one<1>(o[1], vb, pa0, pa1, pa2, pa3); pv_one<2>(o[2], vb, pa0, pa1, pa2, pa3); pv_one<3>(o[3], vb, pa0, pa1, pa2, pa3);
}

__device__ __forceinline__ void attn_unit(const bf16_t* Qb, const bf16_t* Kh, const bf16_t* Vh, int seq, char* lds, float lam, const float* subln, const bf16_t* GAb, bf16_t* CATb, int nostore = 0) {
  int tid_ = threadIdx.x; asm volatile("" : "+v"(tid_));
  const int tid = tid_, wid = __builtin_amdgcn_readfirstlane(tid >> 6), lane = tid & 63, r32 = lane & 31, hi = lane >> 5, c = wid >> 2, wq = wid & 3;
  bf16_t* V_lds = (bf16_t*)lds; bf16_t* K_lds = (bf16_t*)(lds + 2 * SHM_V);
  float* ws = (float*)(lds + 2 * SHM_V + 2 * SHM_K) + wid * 64; float* li_l = ws; float* al_l = ws + 32;
  float m_reg = -1e30f, l_reg = 0; f32x16 o[4] = {}; bf16x8 qr[4];
  const bf16_t* Qw = Qb + (long)(wq * QBLK + r32) * LDQ + c * 64 + hi * 8;
#pragma unroll
  for (int d0 = 0; d0 < 4; ++d0) qr[d0] = ld8(Qw + d0 * 16);
  const int sr = tid >> 4, sc = (tid & 15) * 8, vst0 = v_st(sr, sc), vst1 = v_st(32 + sr, sc);
  const int vb0 = (int)(uintptr_t)V_lds + v_rd_base(lane);
  struct { bf16x8 vs0, vs1, ks0, ks1; } sr_[2];
#define SLOAD(i, k0) do { sr_[i].vs0 = ld8(&Vh[(long)((k0) + sr) * LDK + sc]); sr_[i].vs1 = ld8(&Vh[(long)((k0) + 32 + sr) * LDK + sc]); \
    sr_[i].ks0 = ld8(&Kh[(long)((k0) + sr) * LDK + sc]); sr_[i].ks1 = ld8(&Kh[(long)((k0) + 32 + sr) * LDK + sc]); } while (0)
#define SWRITE(b, i) do { *(bf16x8*)((char*)V_lds + (b) * SHM_V + vst0) = sr_[i].vs0;          \
    *(bf16x8*)((char*)V_lds + (b) * SHM_V + vst1) = sr_[i].vs1; int kc = sc * 2;               \
    *(bf16x8*)((char*)K_lds + (b) * SHM_K + KSWZ(sr, kc)) = sr_[i].ks0;                       \
    *(bf16x8*)((char*)K_lds + (b) * SHM_K + KSWZ(32 + sr, kc)) = sr_[i].ks1; } while (0)
#define SWAIT() asm volatile("s_waitcnt vmcnt(4)" ::: "memory")
#define RESC(a) do { if (__any((a) < 1.f)) { if (hi == 0) al_l[r32] = (a); asm volatile("s_waitcnt lgkmcnt(0)" ::: "memory"); \
    for (int d = 0; d < 4; ++d) for (int r = 0; r < 16; ++r) o[d][r] *= al_l[crow(r, hi)]; } } while (0)
  f32x16 pA0, pA1, pB0, pB1; float mnA, mnB, alA, alB; bf16x8 pa0, pa1, pa2, pa3; const int NT = seq / KVBLK;
  constexpr int SE = 0, SO = 1;
  SLOAD(SE, 0); asm volatile("s_waitcnt vmcnt(0)" ::: "memory"); SWRITE(0, SE); __syncthreads();
  qkt(pA0, pA1, K_lds, qr, r32, hi, c); partialSM(pA0, pA1, m_reg, mnA, alA);
  SLOAD(SO, KVBLK); if (2 < NT) SLOAD(SE, 2 * KVBLK);
  SWAIT(); SWRITE(1, SO); __syncthreads();
  for (int j = 1; j + 1 < NT; j += 2) {
    SBAR(); qkt(pB0, pB1, (bf16_t*)((char*)K_lds + SHM_K), qr, r32, hi, c);
    finishSM(pA0, pA1, alA, l_reg, pa0, pa1, pa2, pa3); SBAR();
    SLOAD(SO, (j + 2) * KVBLK); SBAR();
    pv_d0(o, vb0, pa0, pa1, pa2, pa3); partialSM(pB0, pB1, m_reg, mnB, alB);
    __syncthreads(); SWAIT(); SWRITE(0, SE);
    RESC(alB); __syncthreads();
    SBAR(); qkt(pA0, pA1, K_lds, qr, r32, hi, c);
    finishSM(pB0, pB1, alB, l_reg, pa0, pa1, pa2, pa3); SBAR();
    if (j + 3 < NT) SLOAD(SE, (j + 3) * KVBLK); SBAR();
    pv_d0(o, vb0 + (int)SHM_V, pa0, pa1, pa2, pa3); partialSM(pA0, pA1, m_reg, mnA, alA);
    __syncthreads(); SWAIT(); SWRITE(1, SO);
    RESC(alA); __syncthreads();
  }
  SBAR(); qkt(pB0, pB1, (bf16_t*)((char*)K_lds + SHM_K), qr, r32, hi, c);
  finishSM(pA0, pA1, alA, l_reg, pa0, pa1, pa2, pa3); SBAR();
  pv_d0(o, vb0, pa0, pa1, pa2, pa3); partialSM(pB0, pB1, m_reg, mnB, alB);
  __syncthreads(); RESC(alB);
  finishSM(pB0, pB1, alB, l_reg, pa0, pa1, pa2, pa3); SBAR();
  pv_d0(o, vb0 + (int)SHM_V, pa0, pa1, pa2, pa3);
  if (hi == 0) li_l[r32] = l_reg; asm volatile("s_waitcnt lgkmcnt(0)" ::: "memory");
  float rli[16];
#pragma unroll
  for (int r = 0; r < 16; ++r) rli[r] = __builtin_amdgcn_rcpf(li_l[crow(r, hi)]);
  __syncthreads();
  float* X = (float*)lds + (size_t)wq * (32 * 128);
  if (c == 1) {
#pragma unroll
    for (int r = 0; r < 16; ++r) { const int orow = crow(r, hi); const float f = rli[r] * lam;
#pragma unroll
      for (int d0 = 0; d0 < 4; ++d0) X[orow * 128 + d0 * 32 + r32] = o[d0][r] * f; }
  }
  __syncthreads();
  if (c == 0) {
#pragma unroll
    for (int r = 0; r < 16; ++r) { const int orow = crow(r, hi); float v[4]; float ss = 0.f;
#pragma unroll
      for (int d0 = 0; d0 < 4; ++d0) { v[d0] = o[d0][r] * rli[r] - X[orow * 128 + d0 * 32 + r32]; ss += v[d0] * v[d0]; }
#pragma unroll
      for (int s = 1; s < 32; s <<= 1) ss += __shfl_xor(ss, s);
      const float rs = rsqrtf(ss * (1.f / 128.f) + EPS) * (1.f - LAM_INIT);
#pragma unroll
      for (int d0 = 0; d0 < 4; ++d0) X[orow * 128 + d0 * 32 + r32] = v[d0] * rs; }
    asm volatile("s_waitcnt lgkmcnt(0)" ::: "memory");
    const int ch = lane & 15; float sg[8];
#pragma unroll
    for (int e = 0; e < 8; ++e) sg[e] = subln[ch * 8 + e];
#pragma unroll
    for (int it = 0; it < 8; ++it) { const int row = it * 4 + (lane >> 4); const long grow = (long)(wq * QBLK + row);
      const f32x4 x0 = *(const f32x4*)(X + row * 128 + ch * 8), x1 = *(const f32x4*)(X + row * 128 + ch * 8 + 4);
      const v4u g = *(const v4u*)(GAb + grow * 512 + ch * 8);
      v4u w; w.x = pk2(x0.x * sg[0] * bflo(g.x), x0.y * sg[1] * bfhi(g.x)); w.y = pk2(x0.z * sg[2] * bflo(g.y), x0.w * sg[3] * bfhi(g.y));
      w.z = pk2(x1.x * sg[4] * bflo(g.z), x1.y * sg[5] * bfhi(g.z)); w.w = pk2(x1.z * sg[6] * bflo(g.w), x1.w * sg[7] * bfhi(g.w));
      if (!nostore) *(v4u*)(CATb + grow * 1024 + ch * 8) = w; }
  }
  __syncthreads();
#undef SLOAD
#undef SWRITE
#undef SWAIT
#undef RESC
}
#undef KSWZ
#undef SBAR
}

namespace ssm {
using f32x16 = __attribute__((ext_vector_type(16))) float;
constexpr int SROW = 528;
constexpr size_t WA_ELEMS = 16 * 8 * 64 * 8, WC_ELEMS = 32 * 8 * 64 * 8, W_ELEMS = WA_ELEMS + WC_ELEMS;
constexpr int SIDE_F32 = 2 * 64 * 2 * 2;

struct Cplx { float re, im; };
__device__ __forceinline__ Cplx cmul(Cplx a, Cplx b) { return {a.re * b.re - a.im * b.im, a.re * b.im + a.im * b.re}; }

constexpr int NPART = 8;
__device__ __forceinline__ void precompute(int g, int part, const float* A_re, const float* A_im, const float* log_dt, const float* B_re, const float* B_im, const float* C_re, const float* C_im,
                                           const float* Dskip, bf16_t* W, float* side, LAS unsigned char* lds, int tid) {
    LAS float* apow = (LAS float*)lds;
    LAS float* bbar = (LAS float*)(lds + 17408);
    LAS float* Cc   = (LAS float*)(lds + 35840);
    LAS float* Kt   = (LAS float*)(lds + 52224);
    LAS float* Dl   = (LAS float*)(lds + 84992);
    LAS float* fz   = (LAS float*)(lds + 85056);
#define BBAR(d, p, h) bbar[((d) * 64 + (p)) * 36 + 2 * (h)]
#define CC(d, hp, p) Cc[(((d) * 64 + (p)) * 16 + (hp)) * 2]
    float br[4], bi[4], cr[4], ci[4];
#pragma unroll
    for (int j = 0; j < 4; ++j) { const int idx = tid + 512 * j, d = idx >> 10, rem = idx & 1023; const size_t o = (size_t)(d * 32 + g) * 1024 + rem;
        br[j] = B_re[o]; bi[j] = B_im[o]; cr[j] = C_re[o]; ci[j] = C_im[o]; }
    float ldt = 0.f, Ar = 0.f, Ai = 0.f, dsk = 0.f;
    if (tid < 128) { const int dg = (tid >> 6) * 32 + g; ldt = log_dt[dg]; Ar = A_re[dg * 64 + (tid & 63)]; Ai = A_im[dg * 64 + (tid & 63)]; }
    if (tid < 16) dsk = Dskip[g * 16 + tid];
    if (tid < 128) { const int d = tid >> 6, p = tid & 63;
        const float dt = expf(ldt);
        const float mag = expf(Ar * dt); const Cplx ab = {mag * cosf(Ai * dt), mag * sinf(Ai * dt)};
        const float nr = ab.re - 1.f, ni = ab.im, den = Ar * Ar + Ai * Ai;
        fz[(d * 64 + p) * 2] = (nr * Ar + ni * Ai) / den; fz[(d * 64 + p) * 2 + 1] = (ni * Ar - nr * Ai) / den;
        Cplx pw = {1.f, 0.f};
        for (int m = 0; m <= 16; ++m) { apow[((d * 17 + m) * 64 + p) * 2] = pw.re; apow[((d * 17 + m) * 64 + p) * 2 + 1] = pw.im; if (m < 16) pw = cmul(pw, ab); }
        if (part == 0) { side[(d * 64 + p) * 2] = pw.re; side[(d * 64 + p) * 2 + 1] = pw.im;
            Cplx q = pw; for (int s = 0; s < 4; ++s) q = cmul(q, q);
            side[256 + (d * 64 + p) * 2] = q.re; side[256 + (d * 64 + p) * 2 + 1] = q.im; }
    }
    if (tid < 16) Dl[tid] = dsk;
#pragma unroll
    for (int j = 0; j < 4; ++j) { const int idx = tid + 512 * j, d = idx >> 10, rem = idx & 1023;
        (&CC(d, rem >> 6, rem & 63))[0] = cr[j]; (&CC(d, rem >> 6, rem & 63))[1] = ci[j]; }
    __syncthreads();
#pragma unroll
    for (int j = 0; j < 4; ++j) { const int idx = tid + 512 * j, d = idx >> 10, rem = idx & 1023, p = rem >> 4, h = rem & 15;
        const Cplx f = {fz[(d * 64 + p) * 2], fz[(d * 64 + p) * 2 + 1]}; const Cplx bb = cmul(f, (Cplx){br[j], bi[j]});
        (&BBAR(d, p, h))[0] = bb.re; (&BBAR(d, p, h))[1] = bb.im; }
    __syncthreads();
    { typedef float f32x4_t __attribute__((ext_vector_type(4)));
      const int wv = tid >> 6, l = tid & 63, d = wv >> 2, r16 = l & 15, q4 = l >> 4;
#define SPLIT2(U, V, WH, WL) do { const unsigned h2_ = pg8::cvt_pk_bf16(U, V); WH = h2_; WL = pg8::cvt_pk_bf16((U) - __uint_as_float(h2_ << 16), (V) - __uint_as_float(h2_ & 0xffff0000u)); } while (0)
      bf16x8 bh[4], bl[4];
#pragma unroll
      for (int ks = 0; ks < 4; ++ks) { unsigned wh[4], wl[4];
#pragma unroll
          for (int q = 0; q < 4; ++q) { const int p = 16 * ks + 4 * q4 + q; const float u = (&BBAR(d, p, r16))[0], v = (&BBAR(d, p, r16))[1]; SPLIT2(u, v, wh[q], wl[q]); }
          bh[ks] = __builtin_bit_cast(bf16x8, (v4u){wh[0], wh[1], wh[2], wh[3]}); bl[ks] = __builtin_bit_cast(bf16x8, (v4u){wl[0], wl[1], wl[2], wl[3]}); }
#pragma unroll 1
      for (int t = 0; t < 4; ++t) { const int m = 4 * (wv & 3) + t; f32x4_t acc = {0.f, 0.f, 0.f, 0.f};
#pragma unroll
          for (int ks = 0; ks < 4; ++ks) { unsigned wh[4], wl[4];
#pragma unroll
              for (int q = 0; q < 4; ++q) { const int p = 16 * ks + 4 * q4 + q; const Cplx c = {(&CC(d, r16, p))[0], (&CC(d, r16, p))[1]};
                  const Cplx a = {apow[((d * 17 + m) * 64 + p) * 2], apow[((d * 17 + m) * 64 + p) * 2 + 1]}; const Cplx z = cmul(c, a); const float u = z.re, v = -z.im; SPLIT2(u, v, wh[q], wl[q]); }
              const bf16x8 ah = __builtin_bit_cast(bf16x8, (v4u){wh[0], wh[1], wh[2], wh[3]}), al = __builtin_bit_cast(bf16x8, (v4u){wl[0], wl[1], wl[2], wl[3]});
              acc = __builtin_amdgcn_mfma_f32_16x16x32_bf16(ah, bh[ks], acc, 0, 0, 0); acc = __builtin_amdgcn_mfma_f32_16x16x32_bf16(ah, bl[ks], acc, 0, 0, 0);
              acc = __builtin_amdgcn_mfma_f32_16x16x32_bf16(al, bh[ks], acc, 0, 0, 0); }
          *(LAS f32x4_t*)(Kt + ((d * 16 + m) * 16 + r16) * 16 + 4 * q4) = acc; }
#undef SPLIT2
    }
    __syncthreads();
    for (int o = part * (8192 / NPART) + tid; o < (part + 1) * (8192 / NPART); o += 512) { const int i = o >> 9, nt = (o >> 6) & 7, l = o & 63, d = nt >> 2, q = nt & 3, p = (l & 31) + 32 * (q >> 1), comp = q & 1, m = d == 0 ? 15 - i : i;
        const Cplx a = {apow[((d * 17 + m) * 64 + p) * 2], apow[((d * 17 + m) * 64 + p) * 2 + 1]};
        unsigned w[4];
#pragma unroll
        for (int e2 = 0; e2 < 4; ++e2) { float v[2];
#pragma unroll
            for (int t = 0; t < 2; ++t) { const int h = 8 * (l >> 5) + 2 * e2 + t; const Cplx b = {(&BBAR(d, p, h))[0], (&BBAR(d, p, h))[1]}; const Cplx z = cmul(a, b); v[t] = comp ? z.im : z.re; }
            w[e2] = pg8::cvt_pk_bf16(v[0], v[1]); }
        *(GAS v4u*)(W + (size_t)o * 8) = (v4u){w[0], w[1], w[2], w[3]}; }
    for (int o = part * (16384 / NPART) + tid; o < (part + 1) * (16384 / NPART); o += 512) { const int ks = o >> 9, nt = (o >> 6) & 7, l = o & 63, cq = 32 * nt + (l & 31), j = cq >> 4, hp = cq & 15;
        unsigned w[4];
#pragma unroll
        for (int e2 = 0; e2 < 4; ++e2) { float v[2];
#pragma unroll
            for (int t = 0; t < 2; ++t) { const int e = 2 * e2 + t; float val;
                if (ks < 16) { const int i = ks, h = 8 * (l >> 5) + e; val = 0.f;
                    if (i <= j) val += Kt[((0 * 16 + (j - i)) * 16 + h) * 16 + hp];
                    if (i >= j) val += Kt[((1 * 16 + (i - j)) * 16 + h) * 16 + hp];
#ifndef SSM_PROBE
                    if (i == j && h == hp) val += Dl[h];
#endif
                    }
                else { const int kk = ks - 16, d = kk >> 3, kidx = 16 * (kk & 7) + 8 * (l >> 5) + e, p = kidx >> 1, comp = kidx & 1, m = d == 0 ? j + 1 : 16 - j;
                    const Cplx c = {(&CC(d, hp, p))[0], (&CC(d, hp, p))[1]};
                    const Cplx a = {apow[((d * 17 + m) * 64 + p) * 2], apow[((d * 17 + m) * 64 + p) * 2 + 1]};
                    const Cplx z = cmul(c, a); val = comp ? -z.im : z.re; }
                v[t] = val; }
            w[e2] = pg8::cvt_pk_bf16(v[0], v[1]); }
        *(GAS v4u*)(W + WA_ELEMS + (size_t)o * 8) = (v4u){w[0], w[1], w[2], w[3]}; }
#undef BBAR
#undef CC
    __syncthreads();
}

template <int DIR, int KIND>
__device__ __forceinline__ void scan(const f32x16 (&x)[2][2], Cplx aT, Cplx aT16, Cplx h0, int hi, LAS unsigned char* SL, int col  , int mt0, Cplx (&fin)[2]) {
    Cplx cin[2];
    if (KIND == 1) {
        Cplx e[2];
#pragma unroll
        for (int m = 0; m < 2; ++m) { Cplx a = {0.f, 0.f};
#pragma unroll
            for (int s = 0; s < 16; ++s) { const int r = DIR ? 15 - s : s; const Cplx t = cmul(a, aT); a.re = t.re + x[m][0][r]; a.im = t.im + x[m][1][r]; }
            e[m] = a; }
        Cplx eo[2];
#pragma unroll
        for (int m = 0; m < 2; ++m) { eo[m].re = __shfl_xor(e[m].re, 32); eo[m].im = __shfl_xor(e[m].im, 32); }
        Cplx eA[2], eB[2];
#pragma unroll
        for (int m = 0; m < 2; ++m) { eA[m] = hi ? eo[m] : e[m]; eB[m] = hi ? e[m] : eo[m]; }
        Cplx c00, c01, c10, c11;
        if (DIR == 0) { c00 = h0; Cplx t = cmul(aT16, c00); c01 = {t.re + eA[0].re, t.im + eA[0].im}; t = cmul(aT16, c01); c10 = {t.re + eB[0].re, t.im + eB[0].im}; t = cmul(aT16, c10); c11 = {t.re + eA[1].re, t.im + eA[1].im}; }
        else { c11 = h0; Cplx t = cmul(aT16, c11); c10 = {t.re + eB[1].re, t.im + eB[1].im}; t = cmul(aT16, c10); c01 = {t.re + eA[1].re, t.im + eA[1].im}; t = cmul(aT16, c01); c00 = {t.re + eB[0].re, t.im + eB[0].im}; }
        cin[0] = hi ? c01 : c00; cin[1] = hi ? c11 : c10;
    } else { cin[0] = {0.f, 0.f}; cin[1] = {0.f, 0.f}; }
#pragma unroll
    for (int m = 0; m < 2; ++m) { Cplx s = cin[m];
#pragma unroll
        for (int q = 0; q < 16; ++q) { const int r = DIR ? 15 - q : q; const int rho = (r & 3) + 8 * (r >> 2) + 4 * hi;
            *(LAS unsigned*)(SL + ((mt0 + m) * 32 + rho) * 512 + ((((col >> 3) ^ (rho & 15)) << 4) | ((col & 7) * 2))) = pk2(s.re, s.im);
            const Cplx t = cmul(s, aT); s.re = t.re + x[m][0][r]; s.im = t.im + x[m][1][r]; }
        fin[m] = s; }
}

__device__ __forceinline__ int item_tok(int kind, int b0, int mt, int rho) { const int hr = (rho >> 2) & 1, rr = (rho & 3) + 4 * (rho >> 3);
    return kind ? NTOK_I + (b0 + (mt >> 1)) * 1024 + 16 * (32 * (mt & 1) + 16 * hr + rr) : (b0 + 2 * mt + hr) * 256 + 16 * rr; }
#define SSM_MMA4(ACC, A0, A1, B0, B1) do { \
        ACC[0][0] = __builtin_amdgcn_mfma_f32_32x32x16_bf16(A0, B0, ACC[0][0], 0, 0, 0); ACC[0][1] = __builtin_amdgcn_mfma_f32_32x32x16_bf16(A0, B1, ACC[0][1], 0, 0, 0); \
        ACC[1][0] = __builtin_amdgcn_mfma_f32_32x32x16_bf16(A1, B0, ACC[1][0], 0, 0, 0); ACC[1][1] = __builtin_amdgcn_mfma_f32_32x32x16_bf16(A1, B1, ACC[1][1], 0, 0, 0); } while (0)
__device__ __forceinline__ void item(int g, int kind, int b0, const bf16_t* U, const bf16_t* Wg, const float* side, const float* state_ssm, bf16_t* YS, float* out, LAS unsigned char* lds) {
    int tid_ = threadIdx.x; asm volatile("" : "+v"(tid_));
    const int tid = tid_, wid = __builtin_amdgcn_readfirstlane(tid >> 6), lane = tid & 63, r32 = lane & 31, hi = lane >> 5, mp = wid & 1, nq = wid >> 1;
    LAS unsigned char* UL = lds; LAS unsigned char* SL = lds + 65536;
    const bf16x8* WA = (const bf16x8*)Wg + 2 * nq * 64 + lane; const bf16x8* WC = (const bf16x8*)(Wg + WA_ELEMS) + 2 * nq * 64 + lane;
    {   v4u pc[8];
#pragma unroll
        for (int j = 0; j < 8; ++j) { const int id = tid + 512 * j, row = id >> 5, ch = id & 31;
            pc[j] = *(const GAS v4u*)(U + (size_t)(item_tok(kind, b0, row >> 5, row & 31) + (ch >> 1)) * 512 + g * 16 + (ch & 1) * 8); }
#pragma unroll
        for (int j = 0; j < 8; ++j) { const int id = tid + 512 * j, row = id >> 5, ch = id & 31; *(LAS v4u*)(UL + row * 512 + ((ch ^ (row & 15)) << 4)) = pc[j]; }
    }
    bf16x8 bq[4][2];
#pragma unroll
    for (int s4 = 0; s4 < 4; ++s4) { bq[s4][0] = WA[s4 * 512]; bq[s4][1] = WA[s4 * 512 + 64]; }
    __syncthreads();
    const LAS unsigned char* ua0 = UL + ((2 * mp) * 32 + r32) * 512; const LAS unsigned char* ua1 = ua0 + 32 * 512; const int sw = r32 & 15;
    f32x16 x[2][2];
#pragma unroll
    for (int m = 0; m < 2; ++m)
#pragma unroll
        for (int t = 0; t < 2; ++t) x[m][t] = f32x16{};
#define SSM_STEP(ACC, P0, P1, II, PREF) do { const bf16x8 a0 = *(const LAS bf16x8*)((P0) + (((2 * (II) + hi) ^ sw) << 4)), a1 = *(const LAS bf16x8*)((P1) + (((2 * (II) + hi) ^ sw) << 4)); \
        SSM_MMA4(ACC, a0, a1, bq[i & 3][0], bq[i & 3][1]); __builtin_amdgcn_sched_barrier(0); PREF; __builtin_amdgcn_sched_barrier(0); } while (0)
#pragma unroll 4
    for (int i = 0; i < 12; ++i) SSM_STEP(x, ua0, ua1, i, (bq[i & 3][0] = WA[(i + 4) * 512], bq[i & 3][1] = WA[(i + 4) * 512 + 64]));
#pragma unroll
    for (int i = 12; i < 16; ++i) SSM_STEP(x, ua0, ua1, i, (bq[i & 3][0] = WC[(i - 12) * 512], bq[i & 3][1] = WC[(i - 12) * 512 + 64]));
    { const int d = nq >> 1, p = r32 + 32 * (nq & 1);
      const Cplx aT = {side[(d * 64 + p) * 2], side[(d * 64 + p) * 2 + 1]}, aT16 = {side[256 + (d * 64 + p) * 2], side[256 + (d * 64 + p) * 2 + 1]};
      Cplx h0 = {0.f, 0.f};
      if (kind) { const size_t sb = ((size_t)((b0 + mp) * 2 + d) * 2) * 2048 + g * 64 + p; h0.re = state_ssm[sb]; h0.im = state_ssm[sb + 2048]; }
      Cplx fin[2];
      if (kind) { if (d == 0) scan<0, 1>(x, aT, aT16, h0, hi, SL, d * 128 + 2 * p, 2 * mp, fin); else scan<1, 1>(x, aT, aT16, h0, hi, SL, d * 128 + 2 * p, 2 * mp, fin); }
      else { if (d == 0) scan<0, 0>(x, aT, aT16, h0, hi, SL, d * 128 + 2 * p, 2 * mp, fin); else scan<1, 0>(x, aT, aT16, h0, hi, SL, d * 128 + 2 * p, 2 * mp, fin);
#pragma unroll
          for (int m = 0; m < 2; ++m) { const int b = b0 + 2 * (2 * mp + m) + hi; const size_t sb = ((size_t)(b * 2 + d) * 2) * 2048 + g * 64 + p; out[O_NS + sb] = fin[m].re; out[O_NS + sb + 2048] = fin[m].im; } }
    }
    __syncthreads();
    f32x16 y[2][2];
#pragma unroll
    for (int m = 0; m < 2; ++m)
#pragma unroll
        for (int t = 0; t < 2; ++t) y[m][t] = f32x16{};
    const LAS unsigned char* sa0 = SL + ((2 * mp) * 32 + r32) * 512; const LAS unsigned char* sa1 = sa0 + 32 * 512;
#pragma unroll 4
    for (int i = 0; i < 16; ++i) SSM_STEP(y, ua0, ua1, i, (bq[i & 3][0] = WC[(i + 4) * 512], bq[i & 3][1] = WC[(i + 4) * 512 + 64]));
#pragma unroll 4
    for (int i = 16; i < 28; ++i) SSM_STEP(y, sa0, sa1, i - 16, (bq[i & 3][0] = WC[(i + 4) * 512], bq[i & 3][1] = WC[(i + 4) * 512 + 64]));
#pragma unroll
    for (int i = 28; i < 32; ++i) SSM_STEP(y, sa0, sa1, i - 16, (void)0);
#undef SSM_STEP
    __syncthreads();
#pragma unroll
    for (int m = 0; m < 2; ++m)
#pragma unroll
        for (int r = 0; r < 16; ++r) { const int rho = (r & 3) + 8 * (r >> 2) + 4 * hi, row = (2 * mp + m) * 32 + rho;
#pragma unroll
            for (int t = 0; t < 2; ++t) { const int cq = 64 * nq + 32 * t + r32, ch = cq >> 3;
#ifdef SSM_PROBE
                { const int j = cq >> 4, hp = cq & 15; ((float*)YS)[(size_t)(item_tok(kind, b0, 2 * mp + m, rho) + j) * 512 + g * 16 + hp] = y[m][t][r]; }
#endif
                *(LAS bf16_t*)(UL + row * 512 + ((ch ^ (rho & 15)) << 4) + (cq & 7) * 2) = (bf16_t)f2bf(fast_gelu_tanh(y[m][t][r])); } }
    __syncthreads();
#ifndef SSM_PROBE
#pragma unroll
    for (int j = 0; j < 8; ++j) { const int id = tid + 512 * j, row = id >> 5, ch = id & 31;
        const v4u v = *(const LAS v4u*)(UL + row * 512 + ((ch ^ (row & 15)) << 4));
        *(GAS v4u*)(YS + (size_t)(item_tok(kind, b0, row >> 5, row & 31) + (ch >> 1)) * 512 + g * 16 + (ch & 1) * 8) = v; }
#endif
    __syncthreads();
}
#undef SSM_MMA4
}

constexpr int NWAVES = 8, NTHREADS = 512;
constexpr int RING_BYTES = 131072, LDSCTL_OFF = RING_BYTES, MISC_OFF = LDSCTL_OFF + 320, LDS_BYTES = 147456;
constexpr int CW_BAR = 4096;
static_assert((CW_BAR + XCD_BAR_WORDS) * 4 <= (int)CTL_ZERO_BYTES, "barrier words inside the memset region");
constexpr int NPHASE = 7;

struct Args { const float* in[25]; float* out; unsigned char* ws; int ph_lo, ph_hi; int rep[8]; int p3mask, pad; };

struct Frame {
    LAS unsigned char* lds; int tid, lane, wave, G;
    const float *x_prompt, *x_sample, *cache_k, *cache_v, *state_ssm, *c, *c_ctx, *w_ada, *b_ada, *norm_pre, *norm_post, *w_in, *lambda_qk, *subln;
    const float *A_re, *A_im, *log_dt, *B_re, *B_im, *C_re, *C_im, *ssm_D, *w_glu, *b_glu, *w_out;
    float* out; float *PART, *MISC, *ROPE, *OUT;
    bf16_t *WIN, *WGLU, *WOUT, *XN, *Q, *KALL, *VALL, *GA, *U, *GS, *YS, *CAT, *SSMW; float* SIDE;
};

__device__ __forceinline__ void p0_adaln_part(Frame& F, int wg) {
    const int kb = wg >> 5, cc = wg & 31;
    LAS float* sc = (LAS float*)F.lds;
    LAS float* red = (LAS float*)(F.lds + 8192);
    for (int i = F.tid; i < 9 * 128; i += NTHREADS) { const int ci = i >> 7, k = 128 * kb + (i & 127); const float v = ci == 0 ? F.c_ctx[k] : F.c[(ci - 1) * DM + k]; sc[i] = siluf(v); }
    __syncthreads();
    const int c4 = F.tid % 24, rg = F.tid / 24;
    if (rg < 21) {
        f32x4 w[7];
#pragma unroll
        for (int j = 0; j < 7; ++j) { const int r = rg + 21 * j; w[j] = r < 128 ? *(const GAS f32x4*)(F.w_ada + (size_t)(128 * kb + r) * DIN + 96 * cc + 4 * c4) : (f32x4){0.f, 0.f, 0.f, 0.f}; }
#pragma unroll
        for (int ci = 0; ci < 9; ++ci) { f32x4 a = {0.f, 0.f, 0.f, 0.f};
#pragma unroll
            for (int j = 0; j < 7; ++j) { const int r = rg + 21 * j; const float sv = r < 128 ? sc[ci * 128 + r] : 0.f; a += w[j] * sv; }
            *(LAS f32x4*)(red + (rg * 9 + ci) * 96 + 4 * c4) = a; }
    }
    __syncthreads();
    for (int o = F.tid; o < 9 * 96; o += NTHREADS) { float sum = 0.f;
#pragma unroll
        for (int r = 0; r < 21; ++r) sum += red[r * 864 + o];
        const int ci = o / 96, col = o % 96; F.PART[(size_t)(kb * 9 + ci) * DIN + 96 * cc + col] = sum; }
    __syncthreads();
}
__device__ __forceinline__ void mod_to_lds(Frame& F, LAS float* MODL, int ci0, int ci1, int col0, int n) {
    for (int i = F.tid; i < 2 * n; i += NTHREADS) { const int j = i >= n, col = col0 + (j ? i - n : i), ci = j ? ci1 : ci0; float sum = F.b_ada[col];
#pragma unroll
        for (int kb = 0; kb < 8; ++kb) sum += F.PART[(size_t)(kb * 9 + ci) * DIN + col];
        MODL[i] = sum; }
    __syncthreads();
}
__device__ __forceinline__ void p0_transpose_item(const float* W, int K, int N, bf16_t* WT, LAS float* scr, int item, int lane) {
    const int nblk = N / 32, kb = item / nblk, nb = item % nblk, k0 = 64 * kb, n0 = 32 * nb;
#pragma unroll 8
    for (int i = 0; i < 32; ++i) { const int kk = 2 * i + (lane >> 5); scr[kk * 33 + (lane & 31)] = W[(size_t)(k0 + kk) * N + n0 + (lane & 31)]; }
    LDS_WAIT(); asm volatile("" ::: "memory");
    const int c = lane & 7;
#pragma unroll
    for (int j = 0; j < 4; ++j) { const int n = (lane >> 3) + 8 * j; const LAS float* s = scr + (8 * c) * 33 + n;
        v4u o; o.x = pk2(s[0 * 33], s[1 * 33]); o.y = pk2(s[2 * 33], s[3 * 33]); o.z = pk2(s[4 * 33], s[5 * 33]); o.w = pk2(s[6 * 33], s[7 * 33]);
        *(GAS v4u*)(WT + (size_t)(n0 + n) * K + k0 + 8 * c) = o; }
    LDS_WAIT(); asm volatile("" ::: "memory");
}
__device__ __forceinline__ void p0_prologue(Frame& F, int pm) {
    const int wg = blockIdx.x;
    if (pm & 1) p0_adaln_part(F, wg);
    if ((pm & 2) && wg < 32 * ssm::NPART) { const int g = wg / ssm::NPART;
        ssm::precompute(g, wg % ssm::NPART, F.A_re, F.A_im, F.log_dt, F.B_re, F.B_im, F.C_re, F.C_im, F.ssm_D, F.SSMW + (size_t)g * ssm::W_ELEMS, F.SIDE + g * ssm::SIDE_F32, F.lds, F.tid); }
    if ((pm & 8) && wg == F.G - 1) {
        for (int t = F.tid; t < 1024; t += NTHREADS) { const int pos = t >> 4, f = t & 15; const float inv = powf(10000.f, -(float)f / 16.f), ang = (float)pos * inv;
            F.ROPE[pos * 16 + f] = cosf(ang); F.ROPE[1024 + pos * 16 + f] = sinf(ang); }
        if (F.tid == 0) { float s1 = 0.f, s2 = 0.f; for (int i = 0; i < 64; ++i) { s1 += F.lambda_qk[i] * F.lambda_qk[64 + i]; s2 += F.lambda_qk[128 + i] * F.lambda_qk[192 + i]; }
            F.MISC[0] = expf(s1) - expf(s2) + LAM_INIT; }
    }
    LAS float* scr = (LAS float*)(F.lds + F.wave * 16384);
    const int NGW = F.G * NWAVES, o = wg * NWAVES + F.wave;
    constexpr int I_IN = (DM / 64) * (DIN / 32), I_GLU = (512 / 64) * (512 / 32), I_OUT = (DM / 64) * (DM / 32), NITEMS = I_IN + I_GLU + I_OUT;
    if (pm & 4) for (int it = o; it < NITEMS; it += NGW) {
        int r = it;
        if (r < I_IN) { p0_transpose_item(F.w_in, DM, DIN, F.WIN, scr, r, F.lane); continue; } r -= I_IN;
        if (r < I_GLU) { p0_transpose_item(F.w_glu, 512, 512, F.WGLU, scr, r, F.lane); continue; } r -= I_GLU;
        p0_transpose_item(F.w_out, DM, DM, F.WOUT, scr, r, F.lane);
    }
    if (pm & 8) { const int n4 = 8 * 256 * 512 / 4;
        for (int i = wg * NTHREADS + F.tid; i < 2 * n4; i += F.G * NTHREADS) { const bool isv = i >= n4; const int j = isv ? i - n4 : i;
            const f32x4 v = ((const GAS f32x4*)(isv ? F.cache_v : F.cache_k))[j];
            const int b = j / (256 * 128), rem = j % (256 * 128); v2u w; w.x = pk2(v.x, v.y); w.y = pk2(v.z, v.w);
            ((GAS v2u*)((isv ? F.VALL : F.KALL) + (size_t)(4096 + b * 1280) * 512))[rem] = w; } }
}
__device__ __forceinline__ void p1_prep_x(Frame& F) {
    constexpr int RPB = NTOK / 256;
    const int row0 = blockIdx.x * RPB, ci0 = mod_index(row0), ci1 = mod_index(row0 + RPB - 1);
    LAS float* MODL = (LAS float*)F.lds;
    mod_to_lds(F, MODL, ci0, ci1, 0, 2048);
    for (int m = row0 + F.wave; m < row0 + RPB; m += NWAVES) {
        const float* xr = m < NTOK_I ? F.x_prompt + (size_t)m * DM : F.x_sample + (size_t)(m - NTOK_I) * DM;
        const LAS float* shift = MODL + (mod_index(m) == ci0 ? 0 : 2048); const LAS float* scale = shift + DM;
        f32x4 v[4]; float ss = 0.f;
#pragma unroll
        for (int j = 0; j < 4; ++j) { v[j] = ((const GAS f32x4*)xr)[F.lane + 64 * j]; ss += (v[j].x * v[j].x + v[j].y * v[j].y) + (v[j].z * v[j].z + v[j].w * v[j].w); }
        ss = wave_sum(ss); const float r = rsqrtf(ss * (1.f / DM) + EPS);
#pragma unroll
        for (int j = 0; j < 4; ++j) { const int i4 = F.lane + 64 * j;
            const f32x4 g = ((const GAS f32x4*)F.norm_pre)[i4], sc = ((const LAS f32x4*)scale)[i4], sh = ((const LAS f32x4*)shift)[i4];
            v2u o; o.x = pk2(v[j].x * r * g.x * (1.f + sc.x) + sh.x, v[j].y * r * g.y * (1.f + sc.y) + sh.y);
            o.y = pk2(v[j].z * r * g.z * (1.f + sc.z) + sh.z, v[j].w * r * g.w * (1.f + sc.w) + sh.w);
            ((GAS v2u*)(F.XN + (size_t)m * DM))[i4] = o; }
    }
    __syncthreads();
}
struct EpiIn {
    static constexpr bool PERM = false, AFTER_DRAIN = false;
    bf16_t *Q, *KALL, *VALL, *GA, *U, *GS; float* out; const float* ROPE;
    __device__ __forceinline__ void operator()(const pg8::f32x4 (&acc)[2][2][4][2], const pg8::Unit& u, int wr, int wc, int fr, int fq) const {
        const int sec = u.pn >> 1, cbase = (u.pn & 1) * 256 + wc * 32 + 4 * fq, rbase = u.pm * 256 + wr * 64 + fr;
        const bool g2 = u.pm >= 16, rope = g2 && sec < 2;
#pragma unroll
        for (int ai = 0; ai < 2; ++ai)
#pragma unroll
            for (int m = 0; m < 4; ++m) {
                const int r = rbase + 128 * ai + 16 * m;
                f32x4 cs = {1.f, 1.f, 1.f, 1.f}, sn = {0.f, 0.f, 0.f, 0.f};
                if (rope) { const int t = (r - NTOK_I) & 1023, pos = (wc & 1) ? (t & 63) : (t >> 6);
                    cs = *(const GAS f32x4*)(ROPE + pos * 16 + 4 * fq); sn = *(const GAS f32x4*)(ROPE + 1024 + pos * 16 + 4 * fq); }
                const size_t krow = (size_t)key_row(r);
#pragma unroll
                for (int bj = 0; bj < 2; ++bj) {
                    const f32x4 a0 = acc[ai][bj][m][0], a1 = acc[ai][bj][m][1];
                    const f32x4 v0 = a0 * cs - a1 * sn, v1 = a1 * cs + a0 * sn;
                    const int cc = cbase + 128 * bj;
                    if (sec == 0) { bf16_t* p = Q + (size_t)r * 512 + cc;
                        *(GAS v2u*)p = (v2u){pk2(v0.x, v0.y), pk2(v0.z, v0.w)}; *(GAS v2u*)(p + 16) = (v2u){pk2(v1.x, v1.y), pk2(v1.z, v1.w)}; }
                    else if (sec == 1 || sec == 2) { bf16_t* p = (sec == 1 ? KALL : VALL) + krow * 512 + cc;
                        *(GAS v2u*)p = (v2u){pk2(v0.x, v0.y), pk2(v0.z, v0.w)}; *(GAS v2u*)(p + 16) = (v2u){pk2(v1.x, v1.y), pk2(v1.z, v1.w)};
                        if (!g2) { float* o = out + (sec == 1 ? O_NK : O_NV) + (size_t)r * 512 + cc; *(GAS f32x4*)o = v0; *(GAS f32x4*)(o + 16) = v1; } }
                    else if (sec == 4) { bf16_t* p = U + (size_t)r * 512 + cc;
                        *(GAS v2u*)p = (v2u){pk2(v0.x, v0.y), pk2(v0.z, v0.w)}; *(GAS v2u*)(p + 16) = (v2u){pk2(v1.x, v1.y), pk2(v1.z, v1.w)}; }
                    else { bf16_t* p = (sec == 3 ? GA : GS) + (size_t)r * 512 + cc;
                        *(GAS v2u*)p = (v2u){pk2(fast_silu(v0.x), fast_silu(v0.y)), pk2(fast_silu(v0.z), fast_silu(v0.w))};
                        *(GAS v2u*)(p + 16) = (v2u){pk2(fast_silu(v1.x), fast_silu(v1.y)), pk2(fast_silu(v1.z), fast_silu(v1.w))}; }
                }
            }
    }
};

struct EpiGlu {
    static constexpr bool PERM = true, AFTER_DRAIN = false;
    const bf16_t *YS, *GS; const float* b_glu; bf16_t* CAT;
    __device__ __forceinline__ void operator()(const pg8::f32x4 (&acc)[2][2][4][2], const pg8::Unit& u, int wr, int wc, int fr, int fq) const {
        const int cbase = u.pn * 256 + wc * 32 + 8 * fq, rbase = u.pm * 256 + wr * 64 + fr;
#pragma unroll
        for (int bj = 0; bj < 2; ++bj) { const int c = cbase + 128 * bj;
            const f32x4 b0 = *(const GAS f32x4*)(b_glu + c), b1 = *(const GAS f32x4*)(b_glu + c + 4);
#pragma unroll
            for (int ai = 0; ai < 2; ++ai)
#pragma unroll
                for (int m = 0; m < 4; ++m) { const size_t r = (size_t)(rbase + 128 * ai + 16 * m);
                    const v4u y = *(const GAS v4u*)(YS + r * 512 + c), g = *(const GAS v4u*)(GS + r * 512 + c);
                    const f32x4 a0 = acc[ai][bj][m][0] + b0, a1 = acc[ai][bj][m][1] + b1;
                    v4u o;
                    o.x = pk2(bflo(y.x) * fast_sigmoid(a0.x) * bflo(g.x), bfhi(y.x) * fast_sigmoid(a0.y) * bfhi(g.x));
                    o.y = pk2(bflo(y.y) * fast_sigmoid(a0.z) * bflo(g.y), bfhi(y.y) * fast_sigmoid(a0.w) * bfhi(g.y));
                    o.z = pk2(bflo(y.z) * fast_sigmoid(a1.x) * bflo(g.z), bfhi(y.z) * fast_sigmoid(a1.y) * bfhi(g.z));
                    o.w = pk2(bflo(y.w) * fast_sigmoid(a1.z) * bflo(g.w), bfhi(y.w) * fast_sigmoid(a1.w) * bfhi(g.w));
                    *(GAS v4u*)(CAT + r * 1024 + 512 + c) = o; } }
    }
};
struct EpiOut {
    static constexpr bool PERM = false, AFTER_DRAIN = false;
    float* OUT;
    __device__ __forceinline__ void operator()(const pg8::f32x4 (&acc)[2][2][4][2], const pg8::Unit& u, int wr, int wc, int fr, int fq) const {
        const int cbase = u.pn * 256 + wc * 32 + 4 * fq, rbase = u.pm * 256 + wr * 64 + fr;
#pragma unroll
        for (int ai = 0; ai < 2; ++ai)
#pragma unroll
            for (int m = 0; m < 4; ++m) { float* o = OUT + (size_t)(rbase + 128 * ai + 16 * m) * 1024 + cbase;
#pragma unroll
                for (int bj = 0; bj < 2; ++bj) { *(GAS f32x4*)(o + 128 * bj) = acc[ai][bj][m][0]; *(GAS f32x4*)(o + 128 * bj + 16) = acc[ai][bj][m][1]; } }
    }
};
__device__ __forceinline__ void p6_final(Frame& F) {
    constexpr int RPB = NTOK / 256;
    const int row0 = blockIdx.x * RPB, ci0 = mod_index(row0), ci1 = mod_index(row0 + RPB - 1);
    LAS float* MODL = (LAS float*)F.lds;
    mod_to_lds(F, MODL, ci0, ci1, 2048, 1024);
    for (int m = row0 + F.wave; m < row0 + RPB; m += NWAVES) {
        const float* xr = m < NTOK_I ? F.x_prompt + (size_t)m * DM : F.x_sample + (size_t)(m - NTOK_I) * DM;
        const LAS float* gate = MODL + (mod_index(m) == ci0 ? 0 : 1024); const float* orow = F.OUT + (size_t)m * DM;
        f32x4 v[4]; float ss = 0.f;
#pragma unroll
        for (int j = 0; j < 4; ++j) { v[j] = ((const GAS f32x4*)orow)[F.lane + 64 * j]; ss += (v[j].x * v[j].x + v[j].y * v[j].y) + (v[j].z * v[j].z + v[j].w * v[j].w); }
        ss = wave_sum(ss); const float r = rsqrtf(ss * (1.f / DM) + EPS);
#pragma unroll
        for (int j = 0; j < 4; ++j) { const int i4 = F.lane + 64 * j;
            const f32x4 g = ((const GAS f32x4*)F.norm_post)[i4], ga = ((const LAS f32x4*)gate)[i4], x = ((const GAS f32x4*)xr)[i4];
            ((GAS f32x4*)(F.out + (size_t)m * DM))[i4] = x + ga * (v[j] * r) * g; }
    }
    __syncthreads();
}

__global__ void __launch_bounds__(NTHREADS, 2) mega(Args args) {
    extern __shared__ __attribute__((aligned(16))) unsigned char lds_raw[];
    Frame F;
    F.lds = (LAS unsigned char*)lds_raw; F.tid = threadIdx.x; F.lane = F.tid & 63; F.wave = __builtin_amdgcn_readfirstlane(F.tid >> 6); F.G = gridDim.x;
    volatile LAS unsigned* MISCL = (volatile LAS unsigned*)(F.lds + MISC_OFF);
    unsigned char* ws = args.ws;
    F.x_prompt = args.in[0]; F.x_sample = args.in[1]; F.cache_k = args.in[2]; F.cache_v = args.in[3]; F.state_ssm = args.in[4]; F.c = args.in[5]; F.c_ctx = args.in[6];
    F.w_ada = args.in[7]; F.b_ada = args.in[8]; F.norm_pre = args.in[9]; F.norm_post = args.in[10]; F.w_in = args.in[11]; F.lambda_qk = args.in[12]; F.subln = args.in[13];
    F.A_re = args.in[14]; F.A_im = args.in[15]; F.log_dt = args.in[16]; F.B_re = args.in[17]; F.B_im = args.in[18]; F.C_re = args.in[19]; F.C_im = args.in[20];
    F.ssm_D = args.in[21]; F.w_glu = args.in[22]; F.b_glu = args.in[23]; F.w_out = args.in[24]; F.out = args.out;
    F.PART = (float*)(ws + WS_MOD); F.MISC = (float*)(ws + WS_MISC); F.ROPE = (float*)(ws + WS_ROPE); F.OUT = (float*)(ws + WS_OUT);
    F.WIN = (bf16_t*)(ws + WS_WIN); F.WGLU = (bf16_t*)(ws + WS_WGLU); F.WOUT = (bf16_t*)(ws + WS_WOUT); F.XN = (bf16_t*)(ws + WS_XN); F.Q = (bf16_t*)(ws + WS_Q);
    F.KALL = (bf16_t*)(ws + WS_K); F.VALL = (bf16_t*)(ws + WS_V); F.GA = (bf16_t*)(ws + WS_GA); F.U = (bf16_t*)(ws + WS_U); F.GS = (bf16_t*)(ws + WS_GS);
    F.YS = (bf16_t*)(ws + WS_YS); F.CAT = (bf16_t*)(ws + WS_CAT); F.SSMW = (bf16_t*)(ws + WS_SSMW); F.SIDE = (float*)(ws + WS_SIDE);
    for (int u = F.tid; u < (LDS_BYTES - LDSCTL_OFF) / 4; u += NTHREADS) ((LAS unsigned*)(F.lds + LDSCTL_OFF))[u] = 0u;
    __syncthreads();
    const int lo = args.ph_lo, hi = args.ph_hi;
    XcdBarrier bar; bar.bar = (unsigned*)(ws + WS_CTL) + CW_BAR; bar.x = 0; bar.st = nullptr;
    bar = xcd_barrier_post((unsigned*)(ws + WS_CTL) + CW_BAR, MISCL + 8);
#define IN(k) (lo <= (k) && (k) < hi)
#define SEAM(k) do { if (IN(k) && IN((k) + 1)) xcd_barrier(bar); } while (0)

#define PH0(rp) { p0_prologue(F, (rp) == 0 ? 15 : args.p3mask); }
#define PH1(rp) { p1_prep_x(F); }
#define PH2(rp) { pg8::Gemm g{F.XN, F.WIN, NTOK, DIN, DM}; pg8::StaticOrder S; S.init(NTOK, DIN, F.G, (int)blockIdx.x); \
        EpiIn E{F.Q, F.KALL, F.VALL, F.GA, F.U, F.GS, F.out, F.ROPE}; \
        pg8::gemm_phase<EpiIn, pg8::StaticOrder, true, true>(F.lds, g, S, E); }
#ifdef SSM_PROBE
#define YS_DST (bf16_t*)F.OUT
#else
#define YS_DST F.YS
#endif
#define PH3(rp) { const int pm = (rp) == 0 ? 7 : args.p3mask; \
        const float lam = __uint_as_float(__hip_atomic_load((unsigned*)F.MISC, RLX_AGENT)); \
        const int bx = blockIdx.x, vcu = (F.G % 8 == 0) ? (bx % 8) * (F.G / 8) + bx / 8 : bx;     \
        for (int u0 = vcu; u0 < 512; u0 += F.G) { \
            int u = u0; \
            if (u0 >= 256) {                                     \
                if (u0 < 256 + 192) { const int it = u0 - 256, g = it / 6, sub = it % 6; \
                    if (pm & 2) ssm::item(g, sub < 4 ? 1 : 0, sub < 4 ? 2 * sub : 8 * (sub - 4), F.U, F.SSMW + (size_t)g * ssm::W_ELEMS, F.SIDE + g * ssm::SIDE_F32, F.state_ssm, YS_DST, F.out, F.lds); \
                    continue; } \
                u = 256 + 2 * (u0 - 448); \
                if (!(pm & 4)) continue; \
            } else if (!(pm & 1)) continue; \
            for (int rep = 0; rep < (u0 >= 256 ? 2 : 1); ++rep, ++u) { \
            int tok0, kbase, seq, h; \
            if (u < 256) { const int bh = u >> 3, b = bh >> 2; h = bh & 3; tok0 = NTOK_I + b * 1024 + (u & 7) * 128; kbase = 4096 + b * 1280; seq = 1280; } \
            else { const int s = u - 256, bh = s >> 1, b = bh >> 2; h = bh & 3; tok0 = b * 256 + (s & 1) * 128; kbase = b * 256; seq = 256; } \
            if ((rp) && args.pad) seq = args.pad; \
            att::attn_unit(F.Q + (size_t)tok0 * 512 + h * 128, F.KALL + (size_t)kbase * 512 + h * 128, F.VALL + (size_t)kbase * 512 + h * 128, seq, (char*)lds_raw, lam, \
                           F.subln, F.GA + (size_t)tok0 * 512 + h * 128, F.CAT + (size_t)tok0 * 1024 + h * 128, (rp) && args.pad); \
            } \
        } }
#define PH4(rp) { pg8::Gemm g{F.YS, F.WGLU, NTOK, 512, 512}; pg8::StaticOrder S; S.init(NTOK, 512, F.G, (int)blockIdx.x); \
        EpiGlu E{F.YS, F.GS, F.b_glu, F.CAT}; \
        pg8::gemm_phase<EpiGlu, pg8::StaticOrder, true, true>(F.lds, g, S, E); }
#define PH5(rp) { pg8::Gemm g{F.CAT, F.WOUT, NTOK, DM, DM}; pg8::StaticOrder S; S.init(NTOK, DM, F.G, (int)blockIdx.x); \
        EpiOut E{F.OUT}; \
        pg8::gemm_phase<EpiOut, pg8::StaticOrder, true, true>(F.lds, g, S, E); }
#define PH6(rp) { p6_final(F); }
#ifdef DUP_PHASE
#define RUN(k, BODY) do { if (IN(k)) { BODY(0) if (DUP_PHASE == (k)) { xcd_barrier(bar); BODY(1) } } } while (0)
#else
#define RUN(k, BODY) do { if (IN(k)) { BODY(0) } } while (0)
#endif
    RUN(0, PH0); SEAM(0);
    RUN(1, PH1); SEAM(1);
    RUN(2, PH2); SEAM(2);
    RUN(3, PH3); SEAM(3);
    RUN(4, PH4); SEAM(4);
    RUN(5, PH5); SEAM(5);
    RUN(6, PH6);
#undef RUN
#undef IN
#undef SEAM
}
template <class Epi> __global__ void __launch_bounds__(256) k_gemm_naive(const bf16_t* A, const bf16_t* Bt, int M, int N, int K, Epi E) {
    __shared__ float As[16][65], Bs[16][65];
    const int tx = threadIdx.x & 15, ty = threadIdx.x >> 4, m0 = blockIdx.y * 64, n0 = blockIdx.x * 64;
    float acc[4][4];
#pragma unroll
    for (int i = 0; i < 4; ++i)
#pragma unroll
        for (int j = 0; j < 4; ++j) acc[i][j] = 0.f;
    for (int k0 = 0; k0 < K; k0 += 16) {
#pragma unroll
        for (int i = 0; i < 4; ++i) { const int e = threadIdx.x + 256 * i, r = e >> 4, kk = e & 15;
            As[kk][r] = bf2f(A[(size_t)(m0 + r) * K + k0 + kk]); Bs[kk][r] = bf2f(Bt[(size_t)(n0 + r) * K + k0 + kk]); }
        __syncthreads();
#pragma unroll
        for (int kk = 0; kk < 16; ++kk) { float a[4], b[4];
#pragma unroll
            for (int i = 0; i < 4; ++i) { a[i] = As[kk][ty + 16 * i]; b[i] = Bs[kk][tx + 16 * i]; }
#pragma unroll
            for (int i = 0; i < 4; ++i)
#pragma unroll
                for (int j = 0; j < 4; ++j) acc[i][j] += a[i] * b[j]; }
        __syncthreads();
    }
#pragma unroll
    for (int i = 0; i < 4; ++i) E(m0 + ty + 16 * i, n0, tx, acc[i]);
}
struct EpiInNaive {
    bf16_t *Q, *KALL, *VALL, *GA, *U, *GS; float* out; const float* ROPE;
    __device__ void operator()(int m, int n0, int tx, const float (&v)[4]) const {
        const int sec = n0 >> 9; float w[4] = {v[0], v[1], v[2], v[3]};
        if (sec < 2 && m >= NTOK_I) {
            const int t = (m - NTOK_I) & 1023, prow = t >> 6, pcol = t & 63;
            { const float c = ROPE[prow * 16 + tx], s = ROPE[1024 + prow * 16 + tx]; w[0] = v[0] * c - v[1] * s; w[1] = v[1] * c + v[0] * s; }
            { const float c = ROPE[pcol * 16 + tx], s = ROPE[1024 + pcol * 16 + tx]; w[2] = v[2] * c - v[3] * s; w[3] = v[3] * c + v[2] * s; }
        }
#pragma unroll
        for (int j = 0; j < 4; ++j) { const int cc = (n0 & 511) + tx + 16 * j; const float x = w[j];
            if (sec == 0) Q[(size_t)m * 512 + cc] = f2bf(x);
            else if (sec == 1) { KALL[(size_t)key_row(m) * 512 + cc] = f2bf(x); if (m < NTOK_I) out[O_NK + (size_t)m * 512 + cc] = x; }
            else if (sec == 2) { VALL[(size_t)key_row(m) * 512 + cc] = f2bf(x); if (m < NTOK_I) out[O_NV + (size_t)m * 512 + cc] = x; }
            else if (sec == 3) GA[(size_t)m * 512 + cc] = f2bf(siluf(x));
            else if (sec == 4) U[(size_t)m * 512 + cc] = f2bf(x);
            else GS[(size_t)m * 512 + cc] = f2bf(siluf(x)); }
    }
};
struct EpiGluNaive {
    const bf16_t *YS, *GS; const float* b_glu; bf16_t* CAT;
    __device__ void operator()(int m, int n0, int tx, const float (&v)[4]) const {
#pragma unroll
        for (int j = 0; j < 4; ++j) { const int n = n0 + tx + 16 * j; const float ys = bf2f(YS[(size_t)m * 512 + n]), gs = bf2f(GS[(size_t)m * 512 + n]);
            CAT[(size_t)m * 1024 + 512 + n] = f2bf(ys * sigmoidf(v[j] + b_glu[n]) * gs); }
    }
};
struct EpiOutNaive {
    float* OUT;
    __device__ void operator()(int m, int n0, int tx, const float (&v)[4]) const {
#pragma unroll
        for (int j = 0; j < 4; ++j) OUT[(size_t)m * 1024 + n0 + tx + 16 * j] = v[j];
    }
};

__global__ void __launch_bounds__(256) k_attn_naive(const bf16_t* Q, const bf16_t* KALL, const bf16_t* VALL, const bf16_t* GA, const float* subln, const float* MISC, bf16_t* CAT) {
    __shared__ float P[4][2][1280]; __shared__ float qs[4][128];
    const int h = threadIdx.x >> 6, lane = threadIdx.x & 63, m = blockIdx.x;
    const int kbase = m < NTOK_I ? (m >> 8) * 256 : 4096 + ((m - NTOK_I) >> 10) * 1280, nk = m < NTOK_I ? 256 : 1280;
    const float lam = MISC[0];
    qs[h][lane] = bf2f(Q[(size_t)m * 512 + h * 128 + lane]); qs[h][64 + lane] = bf2f(Q[(size_t)m * 512 + h * 128 + 64 + lane]);
    __syncthreads();
    float mx0 = -1e30f, mx1 = -1e30f;
    for (int kk = lane; kk < nk; kk += 64) { const bf16_t* kr = KALL + (size_t)(kbase + kk) * 512 + h * 128; float s0 = 0.f, s1 = 0.f;
        for (int d = 0; d < 64; ++d) { s0 += qs[h][d] * bf2f(kr[d]); s1 += qs[h][64 + d] * bf2f(kr[64 + d]); }
        s0 *= 0.125f; s1 *= 0.125f; P[h][0][kk] = s0; P[h][1][kk] = s1; mx0 = fmaxf(mx0, s0); mx1 = fmaxf(mx1, s1); }
    mx0 = wave_max(mx0); mx1 = wave_max(mx1);
    float l0 = 0.f, l1 = 0.f;
    for (int kk = lane; kk < nk; kk += 64) { const float p0 = expf(P[h][0][kk] - mx0), p1 = expf(P[h][1][kk] - mx1); P[h][0][kk] = p0; P[h][1][kk] = p1; l0 += p0; l1 += p1; }
    l0 = wave_sum(l0); l1 = wave_sum(l1);
    const float i0 = 1.f / l0, i1 = lam / l1;
    for (int kk = lane; kk < nk; kk += 64) P[h][0][kk] = P[h][0][kk] * i0 - P[h][1][kk] * i1;
    __syncthreads();
    float o0 = 0.f, o1 = 0.f;
    for (int kk = 0; kk < nk; ++kk) { const float w = P[h][0][kk]; const bf16_t* vr = VALL + (size_t)(kbase + kk) * 512 + h * 128; o0 += w * bf2f(vr[lane]); o1 += w * bf2f(vr[64 + lane]); }
    const float ss = wave_sum(o0 * o0 + o1 * o1), r = rsqrtf(ss * (1.f / 128.f) + EPS) * (1.f - LAM_INIT);
    const size_t gi = (size_t)m * 512 + h * 128;
    CAT[(size_t)m * 1024 + h * 128 + lane] = f2bf(o0 * r * subln[lane] * bf2f(GA[gi + lane]));
    CAT[(size_t)m * 1024 + h * 128 + 64 + lane] = f2bf(o1 * r * subln[64 + lane] * bf2f(GA[gi + 64 + lane]));
}

__global__ void __launch_bounds__(64) k_ssm_naive(const bf16_t* U, const float* A_re, const float* A_im, const float* log_dt, const float* B_re, const float* B_im,
                                                  const float* C_re, const float* C_im, const float* state_ssm, float* YF, float* YB, float* out) {
    const int ub = blockIdx.x >> 6, g = (blockIdx.x >> 1) & 31, d = blockIdx.x & 1, p = threadIdx.x;
    const int L = ub < 16 ? 256 : 1024; const size_t tok0 = ub < 16 ? (size_t)ub * 256 : 4096 + (size_t)(ub - 16) * 1024;
    const int dg = d * 32 + g;
    const float dt = expf(log_dt[dg]), Ar = A_re[dg * 64 + p], Ai = A_im[dg * 64 + p];
    const float mag = expf(Ar * dt), abr = mag * cosf(Ai * dt), abi = mag * sinf(Ai * dt);
    const float nr = abr - 1.f, ni = abi, den = Ar * Ar + Ai * Ai, fr = (nr * Ar + ni * Ai) / den, fi = (ni * Ar - nr * Ai) / den;
    float bbr[16], bbi[16], cr[16], ci[16];
#pragma unroll
    for (int h = 0; h < 16; ++h) { const float Br = B_re[(size_t)(dg * 64 + p) * 16 + h], Bi = B_im[(size_t)(dg * 64 + p) * 16 + h];
        bbr[h] = fr * Br - fi * Bi; bbi[h] = fr * Bi + fi * Br; cr[h] = C_re[(size_t)(dg * 16 + h) * 64 + p]; ci[h] = C_im[(size_t)(dg * 16 + h) * 64 + p]; }
    float hr = 0.f, hi = 0.f;
    if (ub >= 16) { const size_t sb = ((size_t)((ub - 16) * 2 + d) * 2) * 2048 + g * 64 + p; hr = state_ssm[sb]; hi = state_ssm[sb + 2048]; }
    float* Y = d == 0 ? YF : YB;
    for (int s = 0; s < L; ++s) { const int t = d == 0 ? s : L - 1 - s;
        const float uval = p < 16 ? bf2f(U[(tok0 + t) * 512 + g * 16 + p]) : 0.f;
        float bur = 0.f, bui = 0.f;
#pragma unroll
        for (int h = 0; h < 16; ++h) { const float uh = __shfl(uval, h); bur += bbr[h] * uh; bui += bbi[h] * uh; }
        const float nhr = abr * hr - abi * hi + bur, nhi = abr * hi + abi * hr + bui; hr = nhr; hi = nhi;
        float yout = 0.f;
#pragma unroll
        for (int hc = 0; hc < 16; ++hc) { const float v = wave_sum(cr[hc] * hr - ci[hc] * hi); if (p == hc) yout = v; }
        if (p < 16) Y[(tok0 + t) * 512 + g * 16 + p] = yout;
    }
    if (ub < 16) { const size_t sb = ((size_t)(ub * 2 + d) * 2) * 2048 + g * 64 + p; out[O_NS + sb] = hr; out[O_NS + sb + 2048] = hi; }
}
__global__ void __launch_bounds__(256) k_ys(const float* YF, const float* YB, const bf16_t* U, const float* Dskip, bf16_t* YS) {
    const size_t n = (size_t)NTOK * 512;
    for (size_t i = blockIdx.x * 256 + threadIdx.x; i < n; i += (size_t)gridDim.x * 256) YS[i] = f2bf(gelu_tanh(YF[i] + YB[i] + Dskip[i & 511] * bf2f(U[i])));
}
__global__ void __launch_bounds__(256) k_final(const float* xp, const float* xs, const float* OUT, const float* norm_post, const float* MOD, float* out) {
    const int gw = (blockIdx.x * 256 + threadIdx.x) >> 6, lane = threadIdx.x & 63, nw = (gridDim.x * 256) >> 6;
    for (int m = gw; m < NTOK; m += nw) {
        const float* xr = m < NTOK_I ? xp + (size_t)m * DM : xs + (size_t)(m - NTOK_I) * DM;
        const float* gate = MOD + mod_index(m) * DIN + 2 * DM; const float* orow = OUT + (size_t)m * DM;
        float4 v[4]; float ss = 0.f;
#pragma unroll
        for (int j = 0; j < 4; ++j) { v[j] = ((const float4*)orow)[lane + 64 * j]; ss += v[j].x * v[j].x + v[j].y * v[j].y + v[j].z * v[j].z + v[j].w * v[j].w; }
        ss = wave_sum(ss); const float r = rsqrtf(ss * (1.f / DM) + EPS);
#pragma unroll
        for (int j = 0; j < 4; ++j) { const int i4 = lane + 64 * j; const float4 g = ((const float4*)norm_post)[i4], ga = ((const float4*)gate)[i4], x = ((const float4*)xr)[i4];
            float4 o; o.x = x.x + ga.x * v[j].x * r * g.x; o.y = x.y + ga.y * v[j].y * r * g.y; o.z = x.z + ga.z * v[j].z * r * g.z; o.w = x.w + ga.w * v[j].w * r * g.w;
            ((float4*)(out + (size_t)m * DM))[i4] = o; }
    }
}


#ifdef SSM_PROBE
__global__ void __launch_bounds__(256) k_probe_cmp(const float* YO, const float* YF, const float* YB, float* acc) {
    float num = 0.f, den = 0.f; const size_t n = (size_t)NTOK * 512;
    for (size_t i = blockIdx.x * 256 + threadIdx.x; i < n; i += (size_t)gridDim.x * 256) { const float r = YF[i] + YB[i], d = YO[i] - r; num += d * d; den += r * r; }
    num = wave_sum(num); den = wave_sum(den);
    if ((threadIdx.x & 63) == 0) { atomicAdd(acc, num); atomicAdd(acc + 1, den); }
}
__global__ void __launch_bounds__(256) k_probe_poke(float* out, const float* acc) {
    const float f = 1.f + sqrtf(acc[0] / acc[1]);
    for (size_t i = blockIdx.x * 256 + threadIdx.x; i < 4194304; i += (size_t)gridDim.x * 256) out[i] *= f;
}
#endif
static void launch_mega(const Args& a0, int lo, int hi, int grid, hipStream_t stream) {
    Args a = a0; a.ph_lo = lo; a.ph_hi = hi;
    void* params[] = {&a};
    hipError_t e = hipLaunchCooperativeKernel((const void*)mega, dim3(grid), dim3(NTHREADS), params, LDS_BYTES, stream);
    if (e != hipSuccess) fprintf(stderr, "kernel_launch: cooperative launch [%d,%d) failed: %s (grid %d)\n", lo, hi, hipGetErrorString(e), grid);
}
extern "C" void kernel_launch(void* const* d_in, const int* in_sizes, int n_in, void* d_out, int out_size, void* d_ws, size_t ws_size, hipStream_t stream) {
    static int grid = 0;
    if (grid == 0) {
        if (n_in != 25 || ws_size < WS_END) { fprintf(stderr, "kernel_launch: unexpected n_in %d / ws %zu\n", n_in, ws_size); grid = -1; return; }
        int dev = 0, cus = 0, per_cu = 0;
        hipGetDevice(&dev); hipDeviceGetAttribute(&cus, hipDeviceAttributeMultiprocessorCount, dev);
        if (hipFuncSetAttribute((const void*)mega, hipFuncAttributeMaxDynamicSharedMemorySize, LDS_BYTES) != hipSuccess) { fprintf(stderr, "kernel_launch: hipFuncSetAttribute failed\n"); grid = -1; return; }
        hipOccupancyMaxActiveBlocksPerMultiprocessor(&per_cu, (const void*)mega, NTHREADS, LDS_BYTES);
        (void)hipGetLastError();
        if (per_cu < 1) fprintf(stderr, "kernel_launch: occupancy query reports %d blocks per CU\n", per_cu);
        grid = cus;
        if (grid != 256) { fprintf(stderr, "kernel_launch: built for a 256-CU device (work decomposition assumes a grid of 256), found %d CUs\n", cus); grid = -1; return; }
    }
    if (grid < 0) return;
    const float* x_prompt = (const float*)d_in[0]; const float* x_sample = (const float*)d_in[1];
    const float* state_ssm = (const float*)d_in[4];
    const float* norm_post = (const float*)d_in[10];
    const float* subln = (const float*)d_in[13]; const float* A_re = (const float*)d_in[14]; const float* A_im = (const float*)d_in[15];
    const float* log_dt = (const float*)d_in[16]; const float* B_re = (const float*)d_in[17]; const float* B_im = (const float*)d_in[18]; const float* C_re = (const float*)d_in[19];
    const float* C_im = (const float*)d_in[20]; const float* ssm_D = (const float*)d_in[21]; const float* b_glu = (const float*)d_in[23];
    float* out = (float*)d_out; char* ws = (char*)d_ws;
    float* MOD = (float*)(ws + WS_MOD); float* MISC = (float*)(ws + WS_MISC);
    bf16_t* WGLU = (bf16_t*)(ws + WS_WGLU); bf16_t* WOUT = (bf16_t*)(ws + WS_WOUT);
    bf16_t* Q = (bf16_t*)(ws + WS_Q); bf16_t* KALL = (bf16_t*)(ws + WS_K); bf16_t* VALL = (bf16_t*)(ws + WS_V);
    bf16_t* GA = (bf16_t*)(ws + WS_GA); bf16_t* U = (bf16_t*)(ws + WS_U); bf16_t* GS = (bf16_t*)(ws + WS_GS); bf16_t* YS = (bf16_t*)(ws + WS_YS);
    bf16_t* CAT = (bf16_t*)(ws + WS_CAT); float* OUT = (float*)(ws + WS_OUT); float* YF = (float*)(ws + WS_YF); float* YB = (float*)(ws + WS_YB);

    hipMemsetAsync(ws + WS_CTL, 0, CTL_ZERO_BYTES, stream);
    Args a{};
    for (int i = 0; i < 25; ++i) a.in[i] = (const float*)d_in[i];
    a.out = out; a.ws = (unsigned char*)d_ws;
    for (int k = 0; k < 8; ++k) a.rep[k] = 1;
    a.p3mask = 7;
#ifdef DUP_PHASE
#ifdef DUP_SEQ
    a.pad = DUP_SEQ;
#endif
#ifdef DUP_P3MASK
    a.p3mask = DUP_P3MASK;
#endif
#endif
#ifndef SSM_PROBE
    launch_mega(a, 0, 7, grid, stream);
#else
    launch_mega(a, 0, 2, grid, stream);
    launch_mega(a, 2, 3, grid, stream);
    launch_mega(a, 3, 4, grid, stream);
#ifdef SSM_PROBE
    k_ssm_naive<<<24 * 64, 64, 0, stream>>>(U, A_re, A_im, log_dt, B_re, B_im, C_re, C_im, state_ssm, YF, YB, out);
    k_ys<<<2048, 256, 0, stream>>>(YF, YB, U, ssm_D, YS);
    k_probe_cmp<<<1024, 256, 0, stream>>>(OUT, YF, YB, (float*)(ws + WS_CTL) + 60000);
#endif
    launch_mega(a, 4, 5, grid, stream);
    launch_mega(a, 5, 6, grid, stream);
    launch_mega(a, 6, 7, grid, stream);
    k_probe_poke<<<4096, 256, 0, stream>>>(out, (float*)(ws + WS_CTL) + 60000);
#endif
#ifdef SSM_PROBE_NEVER
    k_probe_poke<<<4096, 256, 0, stream>>>(out, (float*)(ws + WS_CTL) + 60000);
#endif
}
```
